# Optimizing an MI355X kernel written in HIP

```python
import math
import jax
import jax.numpy as jnp
from jax import lax
import numpy as np

D_MODEL = 1024
BATCH = 2
SEQ = 8192
DEPTH = 2

GRID_W = 64
CTX_LEN = 256

HY_W = 512
SHORT_K = 3
FILT_BANDS = 16
FILT_EMB = 1 + 2 * FILT_BANDS
FILT_W = 64
DECAY_TARGET = 1e-2
FAST_DECAY_PCT = 0.3
SLOW_DECAY_PCT = 1.5

MLA_HEADS = 8
MLA_NOPE = 64
MLA_ROPE = 32
MLA_V = 64
MLA_QK = MLA_NOPE + MLA_ROPE
MLA_Q_RANK = 256
MLA_KV_RANK = 128

SWA_HEADS = 8
SWA_KV_HEADS = 2
SWA_HD = 64
WINDOW = 128

N_BRANCH = 3
QBLOCK = 128
ROPE_BASE = 10000.0
EPS = 1e-6
NEG = -1e30
ALPHA = (2 * DEPTH) ** 0.25
BETA = (8 * DEPTH) ** -0.25

COLS = (3 * HY_W, HY_W,
        MLA_Q_RANK, MLA_KV_RANK, MLA_ROPE, MLA_HEADS * MLA_V,
        SWA_HEADS * SWA_HD, SWA_KV_HEADS * SWA_HD, SWA_KV_HEADS * SWA_HD, SWA_HEADS * SWA_HD,
        N_BRANCH * D_MODEL)
SPLITS = tuple(int(s) for s in np.cumsum(COLS)[:-1])
P_TOTAL = int(sum(COLS))

kernel_name = 'hybrid_hyena_mla_swa_prefix_trunk'


def _layer_norm(x, g=None, b=None):
    xf = x.astype(jnp.float32)
    mu = jnp.mean(xf, -1, keepdims=True)
    var = jnp.mean(jnp.square(xf - mu), -1, keepdims=True)
    y = (xf - mu) * lax.rsqrt(var + EPS)
    if g is not None:
        y = y * g.astype(jnp.float32) + b.astype(jnp.float32)
    return y.astype(x.dtype)


def _rms_norm(x, g):
    xf = x.astype(jnp.float32)
    y = xf * lax.rsqrt(jnp.mean(jnp.square(xf), -1, keepdims=True) + EPS) * g.astype(jnp.float32)
    return y.astype(x.dtype)


def _split_heads(t, h):
    return t.reshape(t.shape[:-1] + (h, t.shape[-1] // h))


def _rope_1d(x, pos):
    half = x.shape[-1] // 2
    inv = ROPE_BASE ** (-jnp.arange(half, dtype=jnp.float32) / half)
    ang = pos.astype(jnp.float32)[:, None] * inv[None, :]
    cos = jnp.cos(ang)[:, None, :]
    sin = jnp.sin(ang)[:, None, :]
    xf = x.astype(jnp.float32)
    x1, x2 = xf[..., :half], xf[..., half:]
    return jnp.concatenate([x1 * cos - x2 * sin, x1 * sin + x2 * cos], -1).astype(x.dtype)


def _rope_2d(x, rows, cols):
    h = x.shape[-1] // 2
    return jnp.concatenate([_rope_1d(x[..., :h], rows), _rope_1d(x[..., h:], cols)], -1)


def _short_conv(x, w, b):
    L = x.shape[1]
    pad = SHORT_K // 2
    xp = jnp.pad(x, ((0, 0), (pad, pad), (0, 0)))
    y = b
    for k in range(SHORT_K):
        y = y + xp[:, k:k + L] * w[k]
    return y


def _hyena_filters(L, p):
    t = jnp.linspace(0.0, 1.0, L, dtype=jnp.float32)[:, None]
    w = 2.0 * math.pi * jnp.arange(L, dtype=jnp.float32) / L
    f = jnp.linspace(1e-4, FILT_BANDS - 1, FILT_BANDS, dtype=jnp.float32)
    ang = w[:, None] * f[None, :]
    z = jnp.concatenate([t, jnp.cos(ang), -jnp.sin(ang)], -1)
    fr = p['filt_freq'].astype(jnp.float32)
    h = jnp.sin(fr * (z @ p['filt_w1'].astype(jnp.float32) + p['filt_b1'].astype(jnp.float32)))
    h = jnp.sin(fr * (h @ p['filt_w2'].astype(jnp.float32) + p['filt_b2'].astype(jnp.float32)))
    h = jnp.sin(fr * (h @ p['filt_w3'].astype(jnp.float32) + p['filt_b3'].astype(jnp.float32)))
    h = h @ p['filt_w_out'].astype(jnp.float32)
    min_decay = math.log(DECAY_TARGET) / SLOW_DECAY_PCT
    max_decay = math.log(DECAY_TARGET) / FAST_DECAY_PCT
    deltas = jnp.linspace(min_decay, max_decay, HY_W, dtype=jnp.float32)
    decay = jnp.exp(-t * jnp.abs(deltas)[None, :])
    h = h.reshape(L, 2, HY_W) * decay[:, None, :]
    return h[:, 0], h[:, 1]


def _bidir_long_conv(u, h_fwd, h_bwd, skip):
    L = u.shape[1]
    n = 2 * L
    k_full = jnp.concatenate([h_fwd, jnp.zeros((1, HY_W), jnp.float32), h_bwd[1:][::-1]], 0)
    uf = u.astype(jnp.float32)
    y = jnp.fft.irfft(jnp.fft.rfft(uf, n=n, axis=1) * jnp.fft.rfft(k_full, n=n, axis=0)[None], n=n, axis=1)[:, :L]
    return (y + uf * skip.astype(jnp.float32)).astype(u.dtype)


def _hyena_mixer(xv, p):
    L = xv.shape[1]
    z = _short_conv(xv, p['hy_conv_w'], p['hy_conv_b'])
    x0, x1, v = jnp.split(z, 3, axis=-1)
    h_fwd, h_bwd = _hyena_filters(L, p)
    return _bidir_long_conv(v * x1, h_fwd, h_bwd, p['hy_skip']) * x0


def _mla_q(cq, p, rows, cols):
    q = _split_heads(_rms_norm(cq, p['mla_q_norm']) @ p['mla_w_uq'], MLA_HEADS)
    q_nope, q_rope = q[..., :MLA_NOPE], q[..., MLA_NOPE:]
    if rows is not None:
        q_rope = _rope_2d(q_rope, rows, cols)
    return jnp.concatenate([q_nope, q_rope], -1)


def _mla_kv(ckv, kr, p, rows, cols):
    kv = _split_heads(_rms_norm(ckv, p['mla_kv_norm']) @ p['mla_w_ukv'], MLA_HEADS)
    k_nope, v = kv[..., :MLA_NOPE], kv[..., MLA_NOPE:]
    kr = kr[..., None, :]
    if rows is not None:
        kr = _rope_2d(kr, rows, cols)
    k = jnp.concatenate([k_nope, jnp.broadcast_to(kr, k_nope.shape[:-1] + (MLA_ROPE,))], -1)
    return k, v


def _dense_attention(q, k, v, scale):
    s = jnp.einsum('bqhd,bkhd->bhqk', q, k).astype(jnp.float32) * scale
    pr = jax.nn.softmax(s, -1).astype(v.dtype)
    return jnp.einsum('bhqk,bkhd->bqhd', pr, v)


def _block_dense_attention(q, k, v, scale):
    B, S, H, Dq = q.shape
    nb = S // QBLOCK
    qb = jnp.swapaxes(q.reshape(B, nb, QBLOCK, H, Dq), 0, 1)
    o = lax.map(lambda qi: _dense_attention(qi, k, v, scale), qb)
    return jnp.swapaxes(o, 0, 1).reshape(B, S, H * v.shape[-1])


def _swa_latent(q, k, v, kc, vc, sink):
    B, S, H, Dh = q.shape
    G = k.shape[2]
    R = H // G
    W = WINDOW
    nb = S // W
    Lc = kc.shape[1]
    scale = Dh ** -0.5
    qb = jnp.swapaxes(q.reshape(B, nb, W, G, R, Dh), 0, 1)
    pad = ((0, 0), (W, W), (0, 0), (0, 0))
    kp = jnp.pad(k, pad)
    vp = jnp.pad(v, pad)
    band = jnp.abs(W + jnp.arange(W)[:, None] - jnp.arange(3 * W)[None, :]) <= W
    sink_l = jnp.broadcast_to(sink.astype(jnp.float32).reshape(G, R)[None, :, :, None, None], (B, G, R, W, 1))

    def block(args):
        i, qi = args
        kw = lax.dynamic_slice_in_dim(kp, i * W, 3 * W, axis=1)
        vw = lax.dynamic_slice_in_dim(vp, i * W, 3 * W, axis=1)
        kpos = (i - 1) * W + jnp.arange(3 * W)
        valid = band & ((kpos >= 0) & (kpos < S))[None, :]
        s_w = jnp.einsum('bqgrd,bkgd->bgrqk', qi, kw).astype(jnp.float32) * scale
        s_w = jnp.where(valid, s_w, NEG)
        s_c = jnp.einsum('bqgrd,bkgd->bgrqk', qi, kc).astype(jnp.float32) * scale
        pr = jax.nn.softmax(jnp.concatenate([sink_l, s_c, s_w], -1), -1).astype(v.dtype)
        return (jnp.einsum('bgrqk,bkgd->bqgrd', pr[..., 1:1 + Lc], vc)
                + jnp.einsum('bgrqk,bkgd->bqgrd', pr[..., 1 + Lc:], vw))

    o = lax.map(block, (jnp.arange(nb), qb))
    return jnp.swapaxes(o, 0, 1).reshape(B, S, H * Dh)


def _swa_context(q, kc, vc, sink):
    B, Lc, H, Dh = q.shape
    G = kc.shape[2]
    R = H // G
    qg = q.reshape(B, Lc, G, R, Dh)
    s = jnp.einsum('bqgrd,bkgd->bgrqk', qg, kc).astype(jnp.float32) * (Dh ** -0.5)
    s_sink = jnp.broadcast_to(sink.astype(jnp.float32).reshape(G, R)[None, :, :, None, None], (B, G, R, Lc, 1))
    pr = jax.nn.softmax(jnp.concatenate([s_sink, s], -1), -1).astype(vc.dtype)
    return jnp.einsum('bgrqk,bkgd->bqgrd', pr[..., 1:], vc).reshape(B, Lc, H * Dh)


def _merge(y_hy, y_mla, y_swa, g, p):
    g_hy, g_mla, g_swa = jnp.split(g, N_BRANCH, axis=-1)
    m = (jax.nn.sigmoid(g_hy) * (y_hy @ p['w_proj_hy'])
         + jax.nn.sigmoid(g_mla) * (y_mla @ p['w_proj_mla'])
         + jax.nn.sigmoid(g_swa) * (y_swa @ p['w_proj_swa']))
    return m @ p['w_out']


def _modulate(x, mod):
    shift, scale, gate = jnp.split(mod, 3, axis=-1)
    return _layer_norm(x) * (1.0 + scale) + shift, gate


def _trunk_layer(xl, xc, c, c_ctx, rows, cols, p, ctx_out):
    B, Lc = xc.shape[0], xc.shape[1]
    mod_l = (jax.nn.silu(c) @ p['w_ada'] + p['b_ada'])[:, None, :]
    mod_c = jax.nn.silu(c_ctx) @ p['w_ada'] + p['b_ada']
    ul, gate_l = _modulate(xl, mod_l)
    uc, gate_c = _modulate(xc, mod_c)
    (hy_l, hyg_l, cq_l, ckv_l, kr_l, mlag_l, sq_l, sk_l, sv_l, swag_l, mg_l) = jnp.split(ul @ p['w_in'], SPLITS, axis=-1)
    (hy_c, hyg_c, cq_c, ckv_c, kr_c, mlag_c, sq_c, sk_c, sv_c, swag_c, mg_c) = jnp.split(uc @ p['w_in'], SPLITS, axis=-1)

    k_mc, v_mc = _mla_kv(ckv_c, kr_c, p, None, None)
    k_sc = _split_heads(sk_c, SWA_KV_HEADS)
    v_sc = _split_heads(sv_c, SWA_KV_HEADS)

    y_hy = _hyena_mixer(hy_l, p) * jax.nn.silu(hyg_l)
    q_ml = _mla_q(cq_l, p, rows, cols)
    k_ml, v_ml = _mla_kv(ckv_l, kr_l, p, rows, cols)
    y_mla = _block_dense_attention(q_ml, jnp.concatenate([k_mc, k_ml], 1), jnp.concatenate([v_mc, v_ml], 1),
                                   MLA_QK ** -0.5) * jax.nn.silu(mlag_l)
    q_sl = _rope_2d(_split_heads(sq_l, SWA_HEADS), rows, cols)
    k_sl = _rope_2d(_split_heads(sk_l, SWA_KV_HEADS), rows, cols)
    v_sl = _split_heads(sv_l, SWA_KV_HEADS)
    y_swa = _swa_latent(q_sl, k_sl, v_sl, k_sc, v_sc, p['swa_sink']) * jax.nn.silu(swag_l)
    xl_new = _layer_norm(ALPHA * xl + gate_l * _merge(y_hy, y_mla, y_swa, mg_l, p), p['ln_g'], p['ln_b'])
    if not ctx_out:
        return xl_new, xc

    yc_hy = _hyena_mixer(hy_c, p) * jax.nn.silu(hyg_c)
    q_mc = _mla_q(cq_c, p, None, None)
    yc_mla = _dense_attention(q_mc, k_mc, v_mc, MLA_QK ** -0.5).reshape(B, Lc, MLA_HEADS * MLA_V) * jax.nn.silu(mlag_c)
    yc_swa = _swa_context(_split_heads(sq_c, SWA_HEADS), k_sc, v_sc, p['swa_sink']) * jax.nn.silu(swag_c)
    xc_new = _layer_norm(ALPHA * xc + gate_c * _merge(yc_hy, yc_mla, yc_swa, mg_c, p), p['ln_g'], p['ln_b'])
    return xl_new, xc_new


def setup_inputs(seed: int = 0) -> dict:
    key = jax.random.key(seed)
    ks = jax.random.split(key, 32)

    def nrm(k, shape, s):
        return jax.random.normal(k, shape, jnp.float32) * s

    L = DEPTH
    return {
        'x': nrm(ks[0], (BATCH, SEQ, D_MODEL), 1.0),
        'c': nrm(ks[1], (BATCH, D_MODEL), 1.0),
        'ctx': nrm(ks[2], (BATCH, CTX_LEN, D_MODEL), 1.0),
        'c_ctx': nrm(ks[3], (D_MODEL,), 1.0),
        'w_ada': nrm(ks[4], (L, D_MODEL, 3 * D_MODEL), 0.5 * D_MODEL ** -0.5),
        'b_ada': nrm(ks[5], (L, 3 * D_MODEL), 0.01),
        'w_in': nrm(ks[6], (L, D_MODEL, P_TOTAL), D_MODEL ** -0.5),
        'hy_conv_w': nrm(ks[7], (L, SHORT_K, 3 * HY_W), SHORT_K ** -0.5),
        'hy_conv_b': nrm(ks[8], (L, 3 * HY_W), 0.01),
        'filt_w1': nrm(ks[9], (L, FILT_EMB, FILT_W), FILT_EMB ** -0.5),
        'filt_b1': nrm(ks[10], (L, FILT_W), 0.1),
        'filt_w2': nrm(ks[11], (L, FILT_W, FILT_W), FILT_W ** -0.5),
        'filt_b2': nrm(ks[12], (L, FILT_W), 0.1),
        'filt_w3': nrm(ks[13], (L, FILT_W, FILT_W), FILT_W ** -0.5),
        'filt_b3': nrm(ks[14], (L, FILT_W), 0.1),
        'filt_freq': 1.0 + nrm(ks[15], (L, FILT_W), 0.01),
        'filt_w_out': nrm(ks[16], (L, FILT_W, 2 * HY_W), 0.05 * FILT_W ** -0.5),
        'hy_skip': nrm(ks[17], (L, HY_W), 0.5),
        'mla_q_norm': 1.0 + nrm(ks[18], (L, MLA_Q_RANK), 0.01),
        'mla_w_uq': nrm(ks[19], (L, MLA_Q_RANK, MLA_HEADS * MLA_QK), MLA_Q_RANK ** -0.5),
        'mla_kv_norm': 1.0 + nrm(ks[20], (L, MLA_KV_RANK), 0.01),
        'mla_w_ukv': nrm(ks[21], (L, MLA_KV_RANK, MLA_HEADS * (MLA_NOPE + MLA_V)), MLA_KV_RANK ** -0.5),
        'swa_sink': nrm(ks[22], (L, SWA_HEADS), 0.5),
        'w_proj_hy': nrm(ks[23], (L, HY_W, D_MODEL), BETA * HY_W ** -0.5),
        'w_proj_mla': nrm(ks[24], (L, MLA_HEADS * MLA_V, D_MODEL), BETA * (MLA_HEADS * MLA_V) ** -0.5),
        'w_proj_swa': nrm(ks[25], (L, SWA_HEADS * SWA_HD, D_MODEL), BETA * (SWA_HEADS * SWA_HD) ** -0.5),
        'w_out': nrm(ks[26], (L, D_MODEL, D_MODEL), BETA * D_MODEL ** -0.5),
        'ln_g': 1.0 + nrm(ks[27], (L, D_MODEL), 0.01),
        'ln_b': nrm(ks[28], (L, D_MODEL), 0.01),
    }


def reference(x, c, ctx, c_ctx, w_ada, b_ada, w_in, hy_conv_w, hy_conv_b, filt_w1, filt_b1, filt_w2, filt_b2,
              filt_w3, filt_b3, filt_freq, filt_w_out, hy_skip, mla_q_norm, mla_w_uq, mla_kv_norm, mla_w_ukv,
              swa_sink, w_proj_hy, w_proj_mla, w_proj_swa, w_out, ln_g, ln_b):
    S = x.shape[1]
    ROWS = S // GRID_W
    rows = jnp.repeat(jnp.arange(ROWS, dtype=jnp.int32), GRID_W)
    cols = jnp.tile(jnp.arange(GRID_W, dtype=jnp.int32), ROWS)
    xl, xc = x, ctx
    for l in range(DEPTH):
        p = {
            'w_ada': w_ada[l], 'b_ada': b_ada[l], 'w_in': w_in[l],
            'hy_conv_w': hy_conv_w[l], 'hy_conv_b': hy_conv_b[l],
            'filt_w1': filt_w1[l], 'filt_b1': filt_b1[l], 'filt_w2': filt_w2[l], 'filt_b2': filt_b2[l],
            'filt_w3': filt_w3[l], 'filt_b3': filt_b3[l], 'filt_freq': filt_freq[l], 'filt_w_out': filt_w_out[l],
            'hy_skip': hy_skip[l],
            'mla_q_norm': mla_q_norm[l], 'mla_w_uq': mla_w_uq[l],
            'mla_kv_norm': mla_kv_norm[l], 'mla_w_ukv': mla_w_ukv[l],
            'swa_sink': swa_sink[l],
            'w_proj_hy': w_proj_hy[l], 'w_proj_mla': w_proj_mla[l], 'w_proj_swa': w_proj_swa[l], 'w_out': w_out[l],
            'ln_g': ln_g[l], 'ln_b': ln_b[l],
        }
        xl, xc = _trunk_layer(xl, xc, c, c_ctx, rows, cols, p, l < DEPTH - 1)
    return xl
```

```cpp
#include <hip/hip_runtime.h>
#include <hip/hip_cooperative_groups.h>
#include <stdint.h>
#include <stdio.h>
#include <string.h>
namespace cg = cooperative_groups;

#ifndef MULTI_LAUNCH
#define MULTI_LAUNCH 0
#endif

typedef __attribute__((ext_vector_type(8))) short bf16x8;
typedef __attribute__((ext_vector_type(16))) float f32x16;
typedef unsigned short bf16_t;
typedef __attribute__((ext_vector_type(4))) unsigned u32x4;
#define MKFRAG(a, b, c, d) __builtin_bit_cast(bf16x8, (u32x4){(a), (b), (c), (d)})
#define DI __device__ __forceinline__
#define MFMA(a, b, c) __builtin_amdgcn_mfma_f32_32x32x16_bf16((a), (b), (c), 0, 0, 0)

constexpr int S_LAT = 8192, LC = 256, DM = 1024;
constexpr int R_LAT = 16384, R_CTX = 512, R_ALL = 16896;
constexpr int NKEY = 8448;
constexpr int N1 = 4352;
constexpr int NWIN = 7424;
constexpr int P_TOTAL = 7328;

constexpr size_t SZ_U = (size_t)R_ALL * 1024 * 2;
constexpr size_t SZ_HY = (size_t)R_ALL * 1536 * 2;
constexpr size_t OFF_U = 0;
constexpr size_t OFF_HY = OFF_U + SZ_U;
constexpr size_t OFF_QN = OFF_HY;
constexpr size_t OFF_QR = OFF_QN + (size_t)R_ALL * 512 * 2;
constexpr size_t OFF_KN = OFF_QR + (size_t)R_ALL * 256 * 2;
constexpr size_t OFF_M = OFF_HY;
constexpr size_t OFF_GATE = OFF_HY + SZ_HY;
constexpr size_t OFF_CQ = OFF_GATE + SZ_HY;
constexpr size_t OFF_CKV = OFF_CQ + (size_t)R_ALL * 256 * 2;
constexpr size_t OFF_KR = OFF_CKV + (size_t)R_ALL * 128 * 2;
constexpr size_t OFF_SQ = OFF_KR + (size_t)R_ALL * 32 * 2;
constexpr size_t OFF_SK = OFF_SQ + (size_t)R_ALL * 512 * 2;
constexpr size_t OFF_SVT = OFF_SK + (size_t)R_ALL * 128 * 2;
constexpr size_t OFF_VTM = OFF_SVT + (size_t)2 * 2 * 64 * NKEY * 2;
constexpr size_t OFF_UT = OFF_VTM + (size_t)2 * 8 * 64 * NKEY * 2;
constexpr size_t OFF_UC = OFF_UT + (size_t)512 * 16384 * 2;
constexpr size_t OFF_W = OFF_UC + (size_t)512 * 512 * 4;
constexpr size_t WOFF_IN = 0;
constexpr size_t WOFF_UQ = WOFF_IN + (size_t)NWIN * 1024 * 2;
constexpr size_t WOFF_UKV = WOFF_UQ + (size_t)768 * 256 * 2;
constexpr size_t WOFF_P = WOFF_UKV + (size_t)1024 * 128 * 2;
constexpr size_t WOFF_OUT = WOFF_P + (size_t)3 * 1024 * 512 * 2;
constexpr size_t SZ_W = WOFF_OUT + (size_t)1024 * 1024 * 2;
constexpr size_t OFF_FG = OFF_W + SZ_W;
constexpr size_t OFF_FC = OFF_FG + (size_t)512 * 16384 * 2;
constexpr size_t OFF_MOD = OFF_FC + (size_t)512 * 512 * 4;
constexpr size_t OFF_ZC = OFF_MOD + (size_t)2 * 3 * 3072 * 4;
constexpr size_t OFF_CTR = OFF_ZC + (size_t)512 * 1024 * 4;
constexpr size_t OFF_BAR = OFF_CTR + 256;
constexpr size_t OFF_SGC = OFF_BAR + 16384;
constexpr size_t WS_TOTAL = OFF_SGC + (size_t)R_CTX * 3072 * 2;
static_assert(WS_TOTAL <= (size_t)256 * 1024 * 1024, "workspace too large");
static_assert(OFF_KN + (size_t)R_ALL * 512 * 2 <= OFF_GATE, "alias overflow");

struct P {
  const float *x, *c, *ctx, *c_ctx, *w_ada, *b_ada, *w_in, *hy_conv_w, *hy_conv_b;
  const float *fw1, *fb1, *fw2, *fb2, *fw3, *fb3, *ffreq, *fwout, *hy_skip;
  const float *q_norm, *w_uq, *kv_norm, *w_ukv, *sink, *wp_hy, *wp_mla, *wp_swa, *w_out, *ln_g, *ln_b;
  float* out;
  char* ws;
  int phase_lo, phase_hi;
};

DI int tidx() { int t = __builtin_amdgcn_workitem_id_x(); asm volatile("" : "+v"(t)); return t; }
DI float bf2f(unsigned short v) { return __uint_as_float(((unsigned)v) << 16); }
DI float bflo(unsigned v) { return __uint_as_float(v << 16); }
DI float bfhi(unsigned v) { return __uint_as_float(v & 0xffff0000u); }
typedef float f32x2_t __attribute__((ext_vector_type(2)));
typedef __bf16 bf16x2_t __attribute__((ext_vector_type(2)));
DI unsigned pk2(float lo, float hi) {
  f32x2_t v = {lo, hi};
  bf16x2_t b = __builtin_convertvector(v, bf16x2_t);
  return __builtin_bit_cast(unsigned, b);
}
DI unsigned short f2bf(float v) { return (unsigned short)(pk2(v, 0.f) & 0xffffu); }
DI float silu_f(float v) { return v / (1.f + __expf(-v)); }
DI float sigm_f(float v) { return 1.f / (1.f + __expf(-v)); }
DI float wave_sum(float v) {
#pragma unroll
  for (int o = 32; o >= 1; o >>= 1) v += __shfl_xor(v, o);
  return v;
}

#define GL1(V, PTR, LD, KT, P) V = *(const uint4*)((PTR) + (size_t)(rw + 32 * (P)) * (LD) + (KT) * 64 + c8 * 8)
#define G_LOAD(S, KT)                                                                     \
  GL1(S##w0, Wt, ldw, KT, 0); GL1(S##w1, Wt, ldw, KT, 1); GL1(S##w2, Wt, ldw, KT, 2); GL1(S##w3, Wt, ldw, KT, 3); \
  GL1(S##x0, X, ldx, KT, 0);  GL1(S##x1, X, ldx, KT, 1);  GL1(S##x2, X, ldx, KT, 2);  GL1(S##x3, X, ldx, KT, 3)
#define GS1(V, BASE, P) *(uint4*)((BASE) + (rw + 32 * (P)) * 72 + (c8 << 3)) = V
#define G_STORE(S, BUF)                                                                   \
  GS1(S##w0, sW + (BUF) * 9216, 0); GS1(S##w1, sW + (BUF) * 9216, 1); GS1(S##w2, sW + (BUF) * 9216, 2); GS1(S##w3, sW + (BUF) * 9216, 3); \
  GS1(S##x0, sX + (BUF) * 9216, 0); GS1(S##x1, sX + (BUF) * 9216, 1); GS1(S##x2, sX + (BUF) * 9216, 2); GS1(S##x3, sX + (BUF) * 9216, 3)
DI void g_compute(const bf16_t* cw, const bf16_t* cx, f32x16 (&acc)[2][2]) {
  __builtin_amdgcn_s_setprio(1);
#pragma unroll
  for (int ks = 0; ks < 4; ++ks) {
    bf16x8 a[2], b[2];
#pragma unroll
    for (int i = 0; i < 2; ++i) {
      a[i] = *(const bf16x8*)(cw + i * 32 * 72 + ks * 16);
      b[i] = *(const bf16x8*)(cx + i * 32 * 72 + ks * 16);
    }
#pragma unroll
    for (int i = 0; i < 2; ++i)
#pragma unroll
      for (int j = 0; j < 2; ++j) acc[i][j] = MFMA(a[i], b[j], acc[i][j]);
  }
  __builtin_amdgcn_s_setprio(0);
}

template <bool TWO = false>
DI void gemm_core(const bf16_t* __restrict__ Wt, int ldw, const bf16_t* __restrict__ X, int ldx, int K,
                  f32x16 (&acc)[2][2], unsigned char* smem) {
  const int tid = tidx();
  const int lane = tid & 63, wave = tid >> 6;
  const int r = lane & 31, h = lane >> 5;
  const int wn = wave & 1, wm = wave >> 1;
  const int c8 = tid & 7, rw = tid >> 3;
  bf16_t* sW = (bf16_t*)smem;
  bf16_t* sX = (bf16_t*)(smem + 36864);
  const bf16_t* cw = sW + (wn * 64 + r) * 72 + h * 8;
  const bf16_t* cx = sX + (wm * 64 + r) * 72 + h * 8;
  if constexpr (TWO) {
  uint4 ew0, ew1, ew2, ew3, ex0, ex1, ex2, ex3, ow0, ow1, ow2, ow3, ox0, ox1, ox2, ox3;
  const int nk = K >> 6;
  G_LOAD(e, 0);
  G_LOAD(o, 1);
  __syncthreads();
  G_STORE(e, 0);
  if (nk > 2) { G_LOAD(e, 2); }
  __syncthreads();
  for (int kt = 0; kt < nk; kt += 2) {
    g_compute(cw, cx, acc);
    G_STORE(o, 1);
    if (kt + 3 < nk) { G_LOAD(o, kt + 3); }
    __syncthreads();
    g_compute(cw + 9216, cx + 9216, acc);
    if (kt + 2 < nk) {
      G_STORE(e, 0);
      if (kt + 4 < nk) { G_LOAD(e, kt + 4); }
    }
    __syncthreads();
  }
  } else {
  uint4 ew0, ew1, ew2, ew3, ex0, ex1, ex2, ex3;
  const int nk = K >> 6;
  {
    uint4 ow0, ow1, ow2, ow3, ox0, ox1, ox2, ox3;
    G_LOAD(e, 0);
    G_LOAD(o, 1);
    __syncthreads();
    G_STORE(e, 0);
    if (nk > 2) { G_LOAD(e, 2); }
    __syncthreads();
    G_STORE(o, 1);
    g_compute(cw, cx, acc);
    __syncthreads();
  }
#pragma unroll 1
  for (int kt = 1; kt < nk; ++kt) {
    const int cur = kt & 1;
    if (kt + 1 < nk) { G_STORE(e, cur ^ 1); }
    if (kt + 2 < nk) { G_LOAD(e, kt + 2); }
    g_compute(cw + cur * 9216, cx + cur * 9216, acc);
    __syncthreads();
  }
  }
}

DI void zero_acc(f32x16 (&acc)[2][2]) {
#pragma unroll
  for (int i = 0; i < 2; ++i)
#pragma unroll
    for (int j = 0; j < 2; ++j)
#pragma unroll
      for (int k = 0; k < 16; ++k) acc[i][j][k] = 0.f;
}

#define XB_TMO      128
#define XB_XCNT(j)  (256  + 64 * (j))
#define XB_XSUB(j)  (1280 + 64 * (j))
#define XB_XGEN(j)  (2304 + 64 * (j))
#define XB_TOP      3328
#define XB_TOPGEN   3392
#define XCD_BAR_WORDS 3456
#define XB_SPIN_CAP (1u << 18)
#define LAS __attribute__((address_space(3)))

__device__ __forceinline__ unsigned xb_ld(unsigned* p)              { return __hip_atomic_load(p, __ATOMIC_RELAXED, __HIP_MEMORY_SCOPE_AGENT); }
__device__ __forceinline__ unsigned xb_add(unsigned* p, unsigned v) { return __hip_atomic_fetch_add(p, v, __ATOMIC_RELAXED, __HIP_MEMORY_SCOPE_AGENT); }
__device__ __forceinline__ unsigned xb_xcc_id() { return (unsigned)__builtin_amdgcn_s_getreg((3 << 11) | 20) & 0xFu; }
#define XB_SPIN(cond, bar) do { unsigned _sp = 0; while (cond) { __builtin_amdgcn_s_sleep(1); \
    if ((++_sp & 255u) == 0u) { if (xb_ld(&(bar)[XB_TMO])) break; if (_sp > XB_SPIN_CAP) { atomicAdd(&(bar)[XB_TMO], 1u); break; } } } } while (0)

struct XcdBarrier {
    unsigned* bar; unsigned x;
    volatile LAS unsigned* st;
};

__device__ __forceinline__ XcdBarrier xcd_barrier_post(unsigned* bar, volatile LAS unsigned* st) {
    XcdBarrier b; b.bar = bar; b.x = xb_xcc_id(); b.st = st;
    if (threadIdx.x == 0) (void)xb_add(&bar[XB_XCNT(b.x)], 1u);
    return b;
}
__device__ __forceinline__ void xcd_barrier_complete(unsigned* bar, unsigned x, unsigned& nloc, unsigned& nx) {
    const unsigned G = gridDim.x * gridDim.y * gridDim.z;
    unsigned sum, cnt, mine, sp = 0u;
    for (;;) {
        sum = 0u; cnt = 0u; mine = 0u;
#pragma unroll
        for (unsigned j = 0; j < 16; ++j) { const unsigned c = xb_ld(&bar[XB_XCNT(j)]); sum += c; cnt += (c > 0u) ? 1u : 0u; mine = (j == x) ? c : mine; }
        if (sum == G) break;
        __builtin_amdgcn_s_sleep(1);
        if ((++sp & 255u) == 0u) { if (xb_ld(&bar[XB_TMO])) break; if (sp > XB_SPIN_CAP) { atomicAdd(&bar[XB_TMO], 1u); break; } }
    }
    nloc = mine > 0u ? mine : 1u; nx = cnt > 0u ? cnt : 1u;
}

__device__ __forceinline__ void xcd_barrier(const XcdBarrier& b) {
    asm volatile("s_waitcnt vmcnt(0)" ::: "memory");
    __syncthreads();
    if (threadIdx.x == 0) {
        unsigned* bar = b.bar;
        __builtin_amdgcn_s_waitcnt(0);
        unsigned nloc = b.st[0], nx = b.st[1];
        if (nloc == 0u) { xcd_barrier_complete(bar, b.x, nloc, nx); b.st[0] = nloc; b.st[1] = nx; }
        const unsigned old = xb_add(&bar[XB_XSUB(b.x)], 1u);
        const unsigned gen = old / nloc;
        if (old + 1u == (gen + 1u) * nloc) {
            __builtin_amdgcn_fence(__ATOMIC_RELEASE, "agent");
            asm volatile("s_waitcnt vmcnt(0)" ::: "memory");
            const unsigned og = xb_add(&bar[XB_TOP], 1u);
            const unsigned tg = og / nx;
            if (og + 1u == (tg + 1u) * nx) xb_add(&bar[XB_TOPGEN], 1u);
            else XB_SPIN(xb_ld(&bar[XB_TOPGEN]) == tg, bar);
            __builtin_amdgcn_fence(__ATOMIC_ACQUIRE, "agent");
            xb_add(&bar[XB_XGEN(b.x)], 1u);
            asm volatile("s_waitcnt vmcnt(0)" ::: "memory");
        } else {
            XB_SPIN(xb_ld(&bar[XB_XGEN(b.x)]) == gen, bar);
            __builtin_amdgcn_fence(__ATOMIC_ACQUIRE, "agent");
            asm volatile("s_waitcnt vmcnt(0)" ::: "memory");
        }
    }
    __syncthreads();
}


DI void grid_bar(unsigned* bar, unsigned target) {
  __syncthreads();
  if (tidx() == 0) {
    __threadfence();
    __hip_atomic_fetch_add(bar, 1u, __ATOMIC_RELAXED, __HIP_MEMORY_SCOPE_AGENT);
    while (__hip_atomic_load(bar, __ATOMIC_RELAXED, __HIP_MEMORY_SCOPE_AGENT) < target) __builtin_amdgcn_s_sleep(1);
    __threadfence();
  }
  __syncthreads();
}
DI int xcd_item(int k) {
  int nb = gridDim.x, b = blockIdx.x;
  return k * nb + (b & 7) * (nb >> 3) + (b >> 3);
}

struct RowInfo { int isctx, b, prow, pcol, kidx; };
DI RowInfo row_info(int m) {
  RowInfo ri;
  if (m < R_LAT) {
    int t = m & (S_LAT - 1);
    ri.isctx = 0; ri.b = m >> 13; ri.prow = t >> 6; ri.pcol = t & 63; ri.kidx = LC + t;
  } else {
    int i = m - R_LAT;
    ri.isctx = 1; ri.b = i >> 8; ri.prow = 0; ri.pcol = 0; ri.kidx = i & 255;
  }
  return ri;
}

DI void phase_mod(const P& p, unsigned char* smem) {
  float* red = (float*)smem;
  float* sc = (float*)(smem + 4096);
  float* mod = (float*)(p.ws + OFF_MOD);
  const int t = tidx();
  if (blockIdx.x < 192) {
    for (int i = t; i < 3072; i += 256) {
      float v = (i < 2048) ? p.c[i] : p.c_ctx[i - 2048];
      sc[i] = silu_f(v);
    }
    __syncthreads();
  }
  for (int item = blockIdx.x; item < 192; item += gridDim.x) {
    int l = item / 96, j0 = (item % 96) * 32;
    int col = j0 + (t & 31), kq = t >> 5;
    const float* w = p.w_ada + (size_t)l * 1024 * 3072;
    float a0 = 0.f, a1 = 0.f, a2 = 0.f;
#pragma unroll 1
    for (int k0 = kq * 128; k0 < kq * 128 + 128; k0 += 32) {
      float wr[32];
#pragma unroll
      for (int k = 0; k < 32; ++k) wr[k] = w[(size_t)(k0 + k) * 3072 + col];
#pragma unroll
      for (int k = 0; k < 32; ++k) {
        a0 += sc[k0 + k] * wr[k];
        a1 += sc[1024 + k0 + k] * wr[k];
        a2 += sc[2048 + k0 + k] * wr[k];
      }
    }
    __syncthreads();
    red[(0 * 8 + kq) * 32 + (t & 31)] = a0;
    red[(1 * 8 + kq) * 32 + (t & 31)] = a1;
    red[(2 * 8 + kq) * 32 + (t & 31)] = a2;
    __syncthreads();
    if (t < 96) {
      int v = t >> 5, cc = t & 31;
      float s = 0.f;
#pragma unroll
      for (int q = 0; q < 8; ++q) s += red[(v * 8 + q) * 32 + cc];
      mod[(size_t)(l * 3 + v) * 3072 + j0 + cc] = s + p.b_ada[(size_t)l * 3072 + j0 + cc];
    }
    asm volatile("s_waitcnt vmcnt(0)" ::: "memory");
    __syncthreads();
    if (t == 0) {
      __builtin_amdgcn_fence(__ATOMIC_RELEASE, "agent");
      asm volatile("s_waitcnt vmcnt(0)" ::: "memory");
      __hip_atomic_fetch_add((unsigned*)(p.ws + OFF_CTR) + 16, 1u, __ATOMIC_RELAXED, __HIP_MEMORY_SCOPE_AGENT);
    }
  }
}

DI void convert_tile(const float* __restrict__ src, int ldsrc, int c0, int ncols, int K, bf16_t* __restrict__ dst,
                     const float* __restrict__ kscale, int it, unsigned char* smem) {
  float* tile = (float*)smem;
  const int t = tidx();
  const int tx = t & 15, ty = t >> 4;
  const int wn = t >> 2, wk = (t & 3) * 16;
  const int tk = K >> 6;
  int k0 = (it % tk) * 64, n0 = (it / tk) * 64;
  float4 v[4];
  bool okl = (n0 + 4 * tx) < ncols;
#pragma unroll
  for (int i = 0; i < 4; ++i) {
    int kk = ty + 16 * i;
    v[i] = okl ? *(const float4*)(src + (size_t)(k0 + kk) * ldsrc + c0 + n0 + 4 * tx) : make_float4(0.f, 0.f, 0.f, 0.f);
    if (kscale) { float sc = kscale[k0 + kk]; v[i].x *= sc; v[i].y *= sc; v[i].z *= sc; v[i].w *= sc; }
  }
  __syncthreads();
#pragma unroll
  for (int i = 0; i < 4; ++i) {
    int kk = ty + 16 * i;
    tile[kk * 65 + 4 * tx + 0] = v[i].x;
    tile[kk * 65 + 4 * tx + 1] = v[i].y;
    tile[kk * 65 + 4 * tx + 2] = v[i].z;
    tile[kk * 65 + 4 * tx + 3] = v[i].w;
  }
  __syncthreads();
  if (n0 + wn < ncols) {
    unsigned o[8];
#pragma unroll
    for (int j = 0; j < 8; ++j) o[j] = pk2(tile[(wk + 2 * j) * 65 + wn], tile[(wk + 2 * j + 1) * 65 + wn]);
    uint4* d = (uint4*)(dst + (size_t)(n0 + wn) * K + k0 + wk);
    d[0] = make_uint4(o[0], o[1], o[2], o[3]);
    d[1] = make_uint4(o[4], o[5], o[6], o[7]);
  }
}

struct CJob { int src, ld, c0, ncols, K; unsigned dst; int sc; };
#define WIN_E(r) ((unsigned)(WOFF_IN / 2) + (unsigned)(r) * 1024u)
#define WUQ_E(r) ((unsigned)(WOFF_UQ / 2) + (unsigned)(r) * 256u)
__device__ const CJob cjobs[32] = {
    {0, P_TOTAL, 0, 1536, 1024, WIN_E(0), 0},       {0, P_TOTAL, 1536, 512, 1024, WIN_E(1536), 0},
    {0, P_TOTAL, 2464, 512, 1024, WIN_E(2048), 0},  {0, P_TOTAL, 3744, 512, 1024, WIN_E(2560), 0},
    {0, P_TOTAL, 2048, 256, 1024, WIN_E(3072), 0},  {0, P_TOTAL, 2304, 128, 1024, WIN_E(3328), 0},
    {0, P_TOTAL, 2976, 512, 1024, WIN_E(3456), 0},  {0, P_TOTAL, 3488, 128, 1024, WIN_E(3968), 0},
    {0, P_TOTAL, 3616, 128, 1024, WIN_E(4096), 0},  {0, P_TOTAL, 2432, 32, 1024, WIN_E(4224), 0},
    {0, P_TOTAL, 4256, 3072, 1024, WIN_E(4352), 0},
    {1, 768, 0, 64, 256, WUQ_E(0), 1},     {1, 768, 64, 32, 256, WUQ_E(512), 1},
    {1, 768, 96, 64, 256, WUQ_E(64), 1},   {1, 768, 160, 32, 256, WUQ_E(544), 1},
    {1, 768, 192, 64, 256, WUQ_E(128), 1}, {1, 768, 256, 32, 256, WUQ_E(576), 1},
    {1, 768, 288, 64, 256, WUQ_E(192), 1}, {1, 768, 352, 32, 256, WUQ_E(608), 1},
    {1, 768, 384, 64, 256, WUQ_E(256), 1}, {1, 768, 448, 32, 256, WUQ_E(640), 1},
    {1, 768, 480, 64, 256, WUQ_E(320), 1}, {1, 768, 544, 32, 256, WUQ_E(672), 1},
    {1, 768, 576, 64, 256, WUQ_E(384), 1}, {1, 768, 640, 32, 256, WUQ_E(704), 1},
    {1, 768, 672, 64, 256, WUQ_E(448), 1}, {1, 768, 736, 32, 256, WUQ_E(736), 1},
    {2, 1024, 0, 1024, 128, (unsigned)(WOFF_UKV / 2), 2},
    {3, 1024, 0, 1024, 512, (unsigned)(WOFF_P / 2), 0},
    {4, 1024, 0, 1024, 512, (unsigned)(WOFF_P / 2) + 1024u * 512u, 0},
    {5, 1024, 0, 1024, 512, (unsigned)(WOFF_P / 2) + 2u * 1024u * 512u, 0},
    {6, 1024, 0, 1024, 1024, (unsigned)(WOFF_OUT / 2), 0}};

DI void phase_convert(const P& p, int l, unsigned char* smem) {
  bf16_t* W = (bf16_t*)(p.ws + OFF_W);
  for (int i = blockIdx.x * 256 + tidx(); i < 96 * 1024 / 2; i += gridDim.x * 256)
    ((unsigned*)(W + WOFF_IN / 2 + (size_t)4256 * 1024))[i] = 0u;
  int g = blockIdx.x;
  int base = 0;
#pragma unroll 1
  for (int j = 0; j < 32; ++j) {
    CJob jb = cjobs[j];
    int nt = (jb.K >> 6) * ((jb.ncols + 63) >> 6);
    const float* src;
    switch (jb.src) {
      case 0: src = p.w_in + (size_t)l * 1024 * P_TOTAL; break;
      case 1: src = p.w_uq + (size_t)l * 256 * 768; break;
      case 2: src = p.w_ukv + (size_t)l * 128 * 1024; break;
      case 3: src = p.wp_hy + (size_t)l * 512 * 1024; break;
      case 4: src = p.wp_mla + (size_t)l * 512 * 1024; break;
      case 5: src = p.wp_swa + (size_t)l * 512 * 1024; break;
      default: src = p.w_out + (size_t)l * 1024 * 1024; break;
    }
    const float* sc = jb.sc == 1 ? p.q_norm + (size_t)l * 256 : (jb.sc == 2 ? p.kv_norm + (size_t)l * 128 : nullptr);
    while (g < base + nt) {
      convert_tile(src, jb.ld, jb.c0, jb.ncols, jb.K, W + jb.dst, sc, g - base, smem);
      g += gridDim.x;
    }
    base += nt;
  }
}

DI void filter_item(const P& p, int l, int L, int p0, bool isctx, unsigned char* smem) {
  float* zf = (float*)smem;
  float* ha = zf + 16 * 33;
  float* hb = ha + 16 * 64;
  const int t = tidx();
  const float* w1 = p.fw1 + (size_t)l * 33 * 64;
  const float* b1 = p.fb1 + l * 64;
  const float* w2 = p.fw2 + (size_t)l * 64 * 64;
  const float* b2 = p.fb2 + l * 64;
  const float* w3 = p.fw3 + (size_t)l * 64 * 64;
  const float* b3 = p.fb3 + l * 64;
  const float* fr = p.ffreq + l * 64;
  const float* wo = p.fwout + (size_t)l * 64 * 1024;
  __syncthreads();
  for (int i = t; i < 16 * 33; i += 256) {
    int pos = i / 33, f = i % 33;
    int pp = p0 + pos;
    float tt = (float)pp / (float)(L - 1);
    float wv = 6.283185307179586f * (float)pp / (float)L;
    float val;
    if (f == 0) val = tt;
    else {
      int j = (f - 1) & 15;
      float fq = 1e-4f + (float)j * ((15.f - 1e-4f) / 15.f);
      float ang = wv * fq;
      val = (f <= 16) ? __cosf(ang) : -__sinf(ang);
    }
    zf[pos * 33 + f] = val;
  }
  __syncthreads();
  const int unit = t & 63;
  const float fru = fr[unit];
  {
    float s4[4];
#pragma unroll
    for (int i = 0; i < 4; ++i) s4[i] = b1[unit];
#pragma unroll 1
    for (int f0 = 0; f0 < 33; f0 += 11) {
      float wr[11];
#pragma unroll
      for (int f = 0; f < 11; ++f) wr[f] = w1[(f0 + f) * 64 + unit];
#pragma unroll
      for (int f = 0; f < 11; ++f) {
#pragma unroll
        for (int i = 0; i < 4; ++i) s4[i] += zf[((t >> 6) + 4 * i) * 33 + f0 + f] * wr[f];
      }
    }
#pragma unroll
    for (int i = 0; i < 4; ++i) ha[((t >> 6) + 4 * i) * 64 + unit] = __sinf(fru * s4[i]);
  }
  __syncthreads();
  {
    float s4[4];
#pragma unroll
    for (int i = 0; i < 4; ++i) s4[i] = b2[unit];
#pragma unroll 1
    for (int f0 = 0; f0 < 64; f0 += 16) {
      float wr[16];
#pragma unroll
      for (int f = 0; f < 16; ++f) wr[f] = w2[(f0 + f) * 64 + unit];
#pragma unroll
      for (int f = 0; f < 16; ++f) {
#pragma unroll
        for (int i = 0; i < 4; ++i) s4[i] += ha[((t >> 6) + 4 * i) * 64 + f0 + f] * wr[f];
      }
    }
#pragma unroll
    for (int i = 0; i < 4; ++i) hb[((t >> 6) + 4 * i) * 64 + unit] = __sinf(fru * s4[i]);
  }
  __syncthreads();
  {
    float s4[4];
#pragma unroll
    for (int i = 0; i < 4; ++i) s4[i] = b3[unit];
#pragma unroll 1
    for (int f0 = 0; f0 < 64; f0 += 16) {
      float wr[16];
#pragma unroll
      for (int f = 0; f < 16; ++f) wr[f] = w3[(f0 + f) * 64 + unit];
#pragma unroll
      for (int f = 0; f < 16; ++f) {
#pragma unroll
        for (int i = 0; i < 4; ++i) s4[i] += hb[((t >> 6) + 4 * i) * 64 + f0 + f] * wr[f];
      }
    }
#pragma unroll
    for (int i = 0; i < 4; ++i) ha[unit * 16 + ((t >> 6) + 4 * i)] = __sinf(fru * s4[i]);
  }
  __syncthreads();
  const float min_decay = -3.0701134573253945f, max_decay = -15.350567286626973f;
  bf16_t* Fg = (bf16_t*)(p.ws + OFF_FG);
  float* Fc = (float*)(p.ws + OFF_FC);
  float* T = (float*)(smem + 12288);
#pragma unroll 1
  for (int dir = 0; dir < 2; ++dir) {
#pragma unroll 1
    for (int qq = 0; qq < 2; ++qq) {
      int ch = t + 256 * qq;
      int col = dir * 512 + ch;
      float acc[16];
#pragma unroll
      for (int i = 0; i < 16; ++i) acc[i] = 0.f;
#pragma unroll 1
      for (int k0 = 0; k0 < 64; k0 += 16) {
        float wr[16];
#pragma unroll
        for (int k = 0; k < 16; ++k) wr[k] = wo[(k0 + k) * 1024 + col];
#pragma unroll
        for (int k = 0; k < 16; ++k) {
#pragma unroll
          for (int i = 0; i < 16; ++i) acc[i] += ha[(k0 + k) * 16 + i] * wr[k];
        }
      }
      float delta = fabsf(min_decay + (max_decay - min_decay) * ((float)ch / 511.f));
      float skip = p.hy_skip[l * 512 + ch];
#pragma unroll
      for (int i = 0; i < 16; ++i) {
        int pp = p0 + i;
        float tt = (float)pp / (float)(L - 1);
        float v = acc[i] * __expf(-tt * delta);
        if (dir == 0 && pp == 0) v += skip;
        T[ch * 17 + i] = v;
      }
    }
    __syncthreads();
    for (int idx = t; idx < 8192; idx += 256) {
      int ch = idx >> 4, i = idx & 15;
      int pp = p0 + i;
      float v = T[ch * 17 + i];
      if (!isctx) {
        if (dir == 0) Fg[(size_t)ch * 16384 + (8192 - pp)] = f2bf(v);
        else if (pp == 0) Fg[(size_t)ch * 16384] = 0;
        else Fg[(size_t)ch * 16384 + 8192 + pp] = f2bf(v);
      } else {
        if (dir == 0) Fc[(size_t)(255 + pp) * 512 + ch] = v;
        else if (pp > 0) Fc[(size_t)(255 - pp) * 512 + ch] = v;
      }
    }
    __syncthreads();
  }
}

DI void ln_modulate_store(const float4 (&v)[4], const float* __restrict__ modv, bf16_t* __restrict__ urow, int lane) {
  float s = 0.f;
#pragma unroll
  for (int i = 0; i < 4; ++i) s += v[i].x + v[i].y + v[i].z + v[i].w;
  float mean = wave_sum(s) * (1.f / 1024.f);
  float q = 0.f;
#pragma unroll
  for (int i = 0; i < 4; ++i) {
    float a = v[i].x - mean, b = v[i].y - mean, c = v[i].z - mean, d = v[i].w - mean;
    q += a * a + b * b + c * c + d * d;
  }
  float rstd = rsqrtf(wave_sum(q) * (1.f / 1024.f) + 1e-6f);
#pragma unroll
  for (int i = 0; i < 4; ++i) {
    int col = 4 * lane + 256 * i;
    float4 sh = *(const float4*)(modv + col);
    float4 sc = *(const float4*)(modv + 1024 + col);
    float y0 = (v[i].x - mean) * rstd * (1.f + sc.x) + sh.x;
    float y1 = (v[i].y - mean) * rstd * (1.f + sc.y) + sh.y;
    float y2 = (v[i].z - mean) * rstd * (1.f + sc.z) + sh.z;
    float y3 = (v[i].w - mean) * rstd * (1.f + sc.w) + sh.w;
    uint2 o;
    o.x = pk2(y0, y1);
    o.y = pk2(y2, y3);
    *(uint2*)(urow + col) = o;
  }
}

DI void phase_ln0(const P& p) {
  const int lane = tidx() & 63, w = tidx() >> 6;
  bf16_t* U = (bf16_t*)(p.ws + OFF_U);
  const float* mod = (const float*)(p.ws + OFF_MOD);
  for (int item = blockIdx.x; item < R_ALL / 4; item += gridDim.x) {
    int row = item * 4 + w;
    const float* src = row < R_LAT ? p.x + (size_t)row * 1024 : p.ctx + (size_t)(row - R_LAT) * 1024;
    int v = row < R_LAT ? (row >> 13) : 2;
    float4 x[4];
#pragma unroll
    for (int i = 0; i < 4; ++i) x[i] = *(const float4*)(src + 4 * lane + 256 * i);
    ln_modulate_store(x, mod + (size_t)v * 3072, U + (size_t)row * 1024, lane);
  }
}

DI void phase_lnG(const P& p, int l) {
  const int lane = tidx() & 63, w = tidx() >> 6;
  bf16_t* U = (bf16_t*)(p.ws + OFF_U);
  const float* mod = (const float*)(p.ws + OFF_MOD) + (size_t)(l + 1) * 3 * 3072;
  const float* lg = p.ln_g + l * 1024;
  const float* lb = p.ln_b + l * 1024;
  float* zc = (float*)(p.ws + OFF_ZC);
  const int nrows = (l == 0) ? R_ALL : R_LAT;
  for (int item = blockIdx.x; item < nrows / 4; item += gridDim.x) {
    int row = item * 4 + w;
    float* src = row < R_LAT ? p.out + (size_t)row * 1024 : zc + (size_t)(row - R_LAT) * 1024;
    float4 x[4];
    float s = 0.f;
#pragma unroll
    for (int i = 0; i < 4; ++i) {
      x[i] = *(const float4*)(src + 4 * lane + 256 * i);
      s += x[i].x + x[i].y + x[i].z + x[i].w;
    }
    float mean = wave_sum(s) * (1.f / 1024.f);
    float q = 0.f;
#pragma unroll
    for (int i = 0; i < 4; ++i) {
      float a = x[i].x - mean, b = x[i].y - mean, c = x[i].z - mean, d = x[i].w - mean;
      q += a * a + b * b + c * c + d * d;
    }
    float rstd = rsqrtf(wave_sum(q) * (1.f / 1024.f) + 1e-6f);
#pragma unroll
    for (int i = 0; i < 4; ++i) {
      int col = 4 * lane + 256 * i;
      float4 g = *(const float4*)(lg + col);
      float4 b = *(const float4*)(lb + col);
      x[i].x = (x[i].x - mean) * rstd * g.x + b.x;
      x[i].y = (x[i].y - mean) * rstd * g.y + b.y;
      x[i].z = (x[i].z - mean) * rstd * g.z + b.z;
      x[i].w = (x[i].w - mean) * rstd * g.w + b.w;
      if (row < R_LAT) *(float4*)(src + col) = x[i];
    }
    if (l == 0) {
      int v = row < R_LAT ? (row >> 13) : 2;
      ln_modulate_store(x, mod + (size_t)v * 3072, U + (size_t)row * 1024, lane);
    }
  }
}

DI float2 rope16f(float x1, float x2, float pos, int i, float div) {
  float inv = __builtin_amdgcn_exp2f(-(float)i * (13.287712379549449f / div));
  float ang = pos * inv;
  float c = __cosf(ang), s = __sinf(ang);
  return make_float2(x1 * c - x2 * s, x1 * s + x2 * c);
}
#define rope16(X1, X2, POS, I, DIV) do { float2 _rr = rope16f((X1), (X2), (POS), (I), (DIV)); (X1) = _rr.x; (X2) = _rr.y; } while (0)

DI void phase_gemm1(const P& p, int l, unsigned char* smem) {
  const bf16_t* U = (const bf16_t*)(p.ws + OFF_U);
  const bf16_t* Win = (const bf16_t*)(p.ws + OFF_W + WOFF_IN);
  bf16_t* HY = (bf16_t*)(p.ws + OFF_HY);
  bf16_t* GT = (bf16_t*)(p.ws + OFF_GATE);
  bf16_t* CQ = (bf16_t*)(p.ws + OFF_CQ);
  bf16_t* CKV = (bf16_t*)(p.ws + OFF_CKV);
  bf16_t* KR = (bf16_t*)(p.ws + OFF_KR);
  bf16_t* SQ = (bf16_t*)(p.ws + OFF_SQ);
  bf16_t* SK = (bf16_t*)(p.ws + OFF_SK);
  bf16_t* SVT = (bf16_t*)(p.ws + OFF_SVT);
  const int lane = tidx() & 63, wave = tidx() >> 6;
  const int r = lane & 31, h = lane >> 5, wn = wave & 1, wm = wave >> 1;
  const int NMT = R_ALL / 128, NNT = N1 / 128;
  for (int k = 0; k * (int)gridDim.x < NMT * NNT; ++k) {
    int item = xcd_item(k);
    if (item >= NMT * NNT) continue;
    int ntile, mtile;
    if (item < 4 * NMT * 8) { int pnl = item / (NMT * 8), rem = item % (NMT * 8); mtile = rem >> 3; ntile = pnl * 8 + (rem & 7); }
    else { int rem = item - 4 * NMT * 8; mtile = rem >> 1; ntile = 32 + (rem & 1); }
    f32x16 acc[2][2];
    zero_acc(acc);
    gemm_core<true>(Win + (size_t)ntile * 128 * 1024, 1024, U + (size_t)mtile * 128 * 1024, 1024, 1024, acc, smem);
#pragma unroll
    for (int mt = 0; mt < 2; ++mt) {
      int m = mtile * 128 + wm * 64 + mt * 32 + r;
      RowInfo ri = row_info(m);
#pragma unroll
      for (int nt = 0; nt < 2; ++nt) {
        int nl = wn * 64 + nt * 32 + 4 * h;
        f32x16& a = acc[nt][mt];
        if (ntile < 12) {
#pragma unroll
          for (int g = 0; g < 4; ++g) {
            uint2 o = {pk2(a[4 * g], a[4 * g + 1]), pk2(a[4 * g + 2], a[4 * g + 3])};
            *(uint2*)(HY + (size_t)m * 1536 + ntile * 128 + nl + 8 * g) = o;
          }
        } else if (ntile < 24) {
#pragma unroll
          for (int g = 0; g < 4; ++g) {
            uint2 o = {pk2(silu_f(a[4 * g]), silu_f(a[4 * g + 1])), pk2(silu_f(a[4 * g + 2]), silu_f(a[4 * g + 3]))};
            *(uint2*)(GT + (size_t)m * 1536 + (ntile - 12) * 128 + nl + 8 * g) = o;
          }
        } else if (ntile < 26) {
#pragma unroll
          for (int g = 0; g < 4; ++g) {
            uint2 o = {pk2(a[4 * g], a[4 * g + 1]), pk2(a[4 * g + 2], a[4 * g + 3])};
            *(uint2*)(CQ + (size_t)m * 256 + (ntile - 24) * 128 + nl + 8 * g) = o;
          }
        } else if (ntile == 26) {
#pragma unroll
          for (int g = 0; g < 4; ++g) {
            uint2 o = {pk2(a[4 * g], a[4 * g + 1]), pk2(a[4 * g + 2], a[4 * g + 3])};
            *(uint2*)(CKV + (size_t)m * 128 + nl + 8 * g) = o;
          }
        } else if (ntile < 32) {
          float pos = ri.isctx ? 0.f : (nt == 0 ? (float)ri.prow : (float)ri.pcol);
#pragma unroll
          for (int g = 0; g < 2; ++g)
#pragma unroll
            for (int e = 0; e < 4; ++e) rope16(a[4 * g + e], a[4 * (g + 2) + e], pos, 8 * g + 4 * h + e, 16.f);
          const float sc = (ntile < 31) ? 0.125f * 1.4426950408889634f : 1.f;
          bf16_t* dst = (ntile < 31) ? SQ + (size_t)m * 512 + (ntile - 27) * 128 + nl : SK + (size_t)m * 128 + nl;
#pragma unroll
          for (int g = 0; g < 4; ++g) {
            uint2 o = {pk2(a[4 * g] * sc, a[4 * g + 1] * sc), pk2(a[4 * g + 2] * sc, a[4 * g + 3] * sc)};
            *(uint2*)(dst + 8 * g) = o;
          }
        } else if (ntile == 32) {
#pragma unroll
          for (int g = 0; g < 4; ++g)
#pragma unroll
            for (int e = 0; e < 4; ++e) {
              int d = nt * 32 + 8 * g + 4 * h + e;
              SVT[((size_t)(ri.b * 2 + wn) * 64 + d) * NKEY + ri.kidx] = f2bf(a[4 * g + e]);
            }
        } else {
          if (wn == 0 && nt == 0) {
#pragma unroll
            for (int g = 0; g < 4; g += 2) {
              float pos = ri.isctx ? 0.f : (g == 0 ? (float)ri.prow : (float)ri.pcol);
#pragma unroll
              for (int e = 0; e < 4; ++e) rope16(a[4 * g + e], a[4 * (g + 1) + e], pos, 4 * h + e, 8.f);
            }
#pragma unroll
            for (int g = 0; g < 4; ++g) {
              uint2 o = {pk2(a[4 * g], a[4 * g + 1]), pk2(a[4 * g + 2], a[4 * g + 3])};
              *(uint2*)(KR + (size_t)m * 32 + 4 * h + 8 * g) = o;
            }
          }
        }
      }
    }
  }
  if (l == 0) {
    bf16_t* SGC = (bf16_t*)(p.ws + OFF_SGC);
    const int nb = gridDim.x, b = blockIdx.x;
    const int total = NMT * NNT, full = total / nb, remn = total - full * nb;
    const int myidx = (b & 7) * (nb >> 3) + (b >> 3);
    int first, step;
    if (remn > 0 && nb - remn >= 96) { first = (myidx >= remn) ? myidx - remn : 1 << 30; step = 1 << 30; }
    else { first = b; step = nb; }
    for (int e = first; e < 96; e += step) {
      int mtile = 128 + e / 24, nt24 = e % 24;
      f32x16 acc[2][2];
      zero_acc(acc);
      gemm_core<true>(Win + (size_t)(N1 + nt24 * 128) * 1024, 1024, U + (size_t)mtile * 128 * 1024, 1024, 1024, acc, smem);
#pragma unroll
      for (int mt = 0; mt < 2; ++mt) {
        int m = mtile * 128 + wm * 64 + mt * 32 + r - R_LAT;
#pragma unroll
        for (int nt = 0; nt < 2; ++nt) {
          int nl = wn * 64 + nt * 32 + 4 * h;
          f32x16& a = acc[nt][mt];
#pragma unroll
          for (int g = 0; g < 4; ++g) {
            uint2 o = {pk2(sigm_f(a[4 * g]), sigm_f(a[4 * g + 1])), pk2(sigm_f(a[4 * g + 2]), sigm_f(a[4 * g + 3]))};
            *(uint2*)(SGC + (size_t)m * 3072 + nt24 * 128 + nl + 8 * g) = o;
          }
        }
      }
    }
  }
}

DI void phase_hyprep(const P& p, int l, unsigned char* smem) {
  const bf16_t* __restrict__ HY = (const bf16_t*)(p.ws + OFF_HY);
  bf16_t* GT = (bf16_t*)(p.ws + OFF_GATE);
  bf16_t* UT = (bf16_t*)(p.ws + OFF_UT);
  float* UC = (float*)(p.ws + OFF_UC);
  bf16_t* tile = (bf16_t*)smem;
  const float* cw = p.hy_conv_w + (size_t)l * 3 * 1536;
  const float* cb = p.hy_conv_b + (size_t)l * 1536;
  const int t = tidx();
  const int c = 2 * t;
  const int nitems = (l == 0) ? R_ALL / 32 : R_LAT / 32;
  float w0[3][2], w1[3][2], w2[3][2], bb[3][2];
#pragma unroll
  for (int s3 = 0; s3 < 3; ++s3)
#pragma unroll
    for (int e = 0; e < 2; ++e) {
      w0[s3][e] = cw[0 * 1536 + s3 * 512 + c + e];
      w1[s3][e] = cw[1 * 1536 + s3 * 512 + c + e];
      w2[s3][e] = cw[2 * 1536 + s3 * 512 + c + e];
      bb[s3][e] = cb[s3 * 512 + c + e];
    }
  for (int item = blockIdx.x; item < nitems; item += gridDim.x) {
    int r0 = item * 32;
    bool isctx = r0 >= R_LAT;
    int seqlen = isctx ? LC : S_LAT;
    int t0 = isctx ? ((r0 - R_LAT) & (LC - 1)) : (r0 & (S_LAT - 1));
    int b = isctx ? ((r0 - R_LAT) >> 8) : (r0 >> 13);
    unsigned pv[3], cv[3];
#pragma unroll
    for (int s3 = 0; s3 < 3; ++s3) {
      pv[s3] = (t0 > 0) ? *(const unsigned*)(HY + (size_t)(r0 - 1) * 1536 + s3 * 512 + c) : 0u;
      cv[s3] = *(const unsigned*)(HY + (size_t)r0 * 1536 + s3 * 512 + c);
    }
    __syncthreads();
    for (int i0 = 0; i0 < 32; i0 += 16) {
      unsigned nv[16][3], gg[16];
#pragma unroll
      for (int ii = 0; ii < 16; ++ii) {
        int i = i0 + ii;
        bool hasn = (t0 + i + 1) < seqlen;
#pragma unroll
        for (int s3 = 0; s3 < 3; ++s3) nv[ii][s3] = hasn ? *(const unsigned*)(HY + (size_t)(r0 + i + 1) * 1536 + s3 * 512 + c) : 0u;
        gg[ii] = *(const unsigned*)(GT + (size_t)(r0 + i) * 1536 + c);
      }
#pragma unroll
      for (int ii = 0; ii < 16; ++ii) {
        int i = i0 + ii;
        int row = r0 + i;
        float z[3][2];
#pragma unroll
        for (int s3 = 0; s3 < 3; ++s3) {
          z[s3][0] = bb[s3][0] + w0[s3][0] * bflo(pv[s3]) + w1[s3][0] * bflo(cv[s3]) + w2[s3][0] * bflo(nv[ii][s3]);
          z[s3][1] = bb[s3][1] + w0[s3][1] * bfhi(pv[s3]) + w1[s3][1] * bfhi(cv[s3]) + w2[s3][1] * bfhi(nv[ii][s3]);
        }
        float uh0 = z[2][0] * z[1][0], uh1 = z[2][1] * z[1][1];
        *(unsigned*)(GT + (size_t)row * 1536 + c) = pk2(bflo(gg[ii]) * z[0][0], bfhi(gg[ii]) * z[0][1]);
        if (isctx) { *(float2*)(UC + (size_t)(row - R_LAT) * 512 + c) = make_float2(uh0, uh1); }
        else { tile[c * 34 + i] = f2bf(uh0); tile[(c + 1) * 34 + i] = f2bf(uh1); }
#pragma unroll
        for (int s3 = 0; s3 < 3; ++s3) { pv[s3] = cv[s3]; cv[s3] = nv[ii][s3]; }
      }
    }
    __syncthreads();
    if (!isctx) {
      for (int idx = t; idx < 512 * 16; idx += 256) {
        int cl = idx >> 4, pr = idx & 15;
        unsigned v = *(const unsigned*)(tile + cl * 34 + 2 * pr);
        *(unsigned*)(UT + (size_t)cl * 16384 + b * 8192 + t0 + 2 * pr) = v;
      }
    }
  }
}

DI void row_rms(const bf16_t* __restrict__ src, int ld, int ncol, float* rs  ) {
  const int t = tidx();
  int row = t >> 1, hf = t & 1;
  int per = ncol >> 1;
  const bf16_t* q = src + (size_t)row * ld + hf * per;
  float s = 0.f;
  for (int i = 0; i < per; i += 8) {
    uint4 v = *(const uint4*)(q + i);
    float a;
    a = bflo(v.x); s += a * a; a = bfhi(v.x); s += a * a;
    a = bflo(v.y); s += a * a; a = bfhi(v.y); s += a * a;
    a = bflo(v.z); s += a * a; a = bfhi(v.z); s += a * a;
    a = bflo(v.w); s += a * a; a = bfhi(v.w); s += a * a;
  }
  s += __shfl_xor(s, 1);
  if (hf == 0) rs[row] = rsqrtf(s / (float)ncol + 1e-6f);
}

DI void phase_upproj(const P& p, int l, unsigned char* smem, float* rs) {
  const bf16_t* CQ = (const bf16_t*)(p.ws + OFF_CQ);
  const bf16_t* CKV = (const bf16_t*)(p.ws + OFF_CKV);
  const bf16_t* Wuq = (const bf16_t*)(p.ws + OFF_W + WOFF_UQ);
  const bf16_t* Wukv = (const bf16_t*)(p.ws + OFF_W + WOFF_UKV);
  bf16_t* QN = (bf16_t*)(p.ws + OFF_QN);
  bf16_t* QR = (bf16_t*)(p.ws + OFF_QR);
  bf16_t* KN = (bf16_t*)(p.ws + OFF_KN);
  bf16_t* VTM = (bf16_t*)(p.ws + OFF_VTM);
  const int lane = tidx() & 63, wave = tidx() >> 6;
  const int r = lane & 31, h = lane >> 5, wn = wave & 1, wm = wave >> 1;
  const int NMT = R_ALL / 128;
  const int n_kv = NMT * 8;
  const int nmq = (l == 0) ? NMT : R_LAT / 128;
  const int n_q = nmq * 6;
  const float qscale = 0.10206207261596577f * 1.4426950408889634f;
  for (int item = blockIdx.x; item < n_kv + n_q; item += gridDim.x) {
    bool iskv = item < n_kv;
    int mtile, ntile;
    if (iskv) { mtile = item % NMT; ntile = item / NMT; }
    else { int it = item - n_kv; mtile = it % nmq; ntile = it / nmq; }
    f32x16 acc[2][2];
    zero_acc(acc);
    __syncthreads();
    if (iskv) row_rms(CKV + (size_t)mtile * 128 * 128, 128, 128, rs);
    else row_rms(CQ + (size_t)mtile * 128 * 256, 256, 256, rs);
    if (iskv) gemm_core(Wukv + (size_t)ntile * 128 * 128, 128, CKV + (size_t)mtile * 128 * 128, 128, 128, acc, smem);
    else gemm_core(Wuq + (size_t)ntile * 128 * 256, 256, CQ + (size_t)mtile * 128 * 256, 256, 256, acc, smem);
#pragma unroll
    for (int mt = 0; mt < 2; ++mt) {
      int ml = wm * 64 + mt * 32 + r;
      int m = mtile * 128 + ml;
      RowInfo ri = row_info(m);
      float rsv = rs[ml];
#pragma unroll
      for (int nt = 0; nt < 2; ++nt) {
        f32x16& a = acc[nt][mt];
        int nl = wn * 64 + nt * 32 + 4 * h;
        if (iskv) {
          if (wn == 0) {
#pragma unroll
            for (int g = 0; g < 4; ++g) {
              uint2 o = {pk2(a[4 * g] * rsv, a[4 * g + 1] * rsv), pk2(a[4 * g + 2] * rsv, a[4 * g + 3] * rsv)};
              *(uint2*)(KN + (size_t)m * 512 + ntile * 64 + nt * 32 + 4 * h + 8 * g) = o;
            }
          } else {
#pragma unroll
            for (int g = 0; g < 4; ++g)
#pragma unroll
              for (int e = 0; e < 4; ++e) {
                int d = nt * 32 + 8 * g + 4 * h + e;
                VTM[((size_t)(ri.b * 8 + ntile) * 64 + d) * NKEY + ri.kidx] = f2bf(a[4 * g + e] * rsv);
              }
          }
        } else {
          float sc = rsv * qscale;
          if (ntile < 4) {
#pragma unroll
            for (int g = 0; g < 4; ++g) {
              uint2 o = {pk2(a[4 * g] * sc, a[4 * g + 1] * sc), pk2(a[4 * g + 2] * sc, a[4 * g + 3] * sc)};
              *(uint2*)(QN + (size_t)m * 512 + ntile * 128 + nl + 8 * g) = o;
            }
          } else {
#pragma unroll
            for (int g = 0; g < 4; g += 2) {
              float pos = ri.isctx ? 0.f : (g == 0 ? (float)ri.prow : (float)ri.pcol);
#pragma unroll
              for (int e = 0; e < 4; ++e) rope16(a[4 * g + e], a[4 * (g + 1) + e], pos, 4 * h + e, 8.f);
            }
#pragma unroll
            for (int g = 0; g < 4; ++g) {
              uint2 o = {pk2(a[4 * g] * sc, a[4 * g + 1] * sc), pk2(a[4 * g + 2] * sc, a[4 * g + 3] * sc)};
              *(uint2*)(QR + (size_t)m * 256 + (ntile - 4) * 128 + nl + 8 * g) = o;
            }
          }
        }
      }
    }
  }
}

constexpr int KROW = 208;
constexpr int VROW = 136;
constexpr int ATT_BUF = 64 * KROW + 64 * VROW;

template <int DQK>
DI void attn_load(const bf16_t* __restrict__ ka, int lda, const bf16_t* __restrict__ kb, const bf16_t* __restrict__ vt,
                  int krow0, int kcol0, uint4& g0, uint4& g1, uint4& g2, uint4& g3, uint4& g4) {
  const int t = tidx();
  {
    int key = t >> 3, c = t & 7;
    g0 = *(const uint4*)(ka + (size_t)(krow0 + key) * lda + c * 8);
    g1 = *(const uint4*)(ka + (size_t)(krow0 + 32 + key) * lda + c * 8);
    g2 = *(const uint4*)(vt + (size_t)key * NKEY + kcol0 + c * 8);
    g3 = *(const uint4*)(vt + (size_t)(32 + key) * NKEY + kcol0 + c * 8);
  }
  if constexpr (DQK == 96) {
    int key = t >> 2, c = t & 3;
    g4 = *(const uint4*)(kb + (size_t)(krow0 + key) * 32 + c * 8);
  }
}
template <int DQK>
DI void attn_store(unsigned char* buf, const uint4& g0, const uint4& g1, const uint4& g2, const uint4& g3, const uint4& g4) {
  const int t = tidx();
  {
    int key = t >> 3, c = t & 7;
    *(uint4*)(buf + key * KROW + c * 16) = g0;
    *(uint4*)(buf + (32 + key) * KROW + c * 16) = g1;
    unsigned char* q = buf + 64 * KROW + key * VROW + c * 16;
    *(uint2*)(q) = make_uint2(g2.x, g2.y);
    *(uint2*)(q + 8) = make_uint2(g2.z, g2.w);
    q += 32 * VROW;
    *(uint2*)(q) = make_uint2(g3.x, g3.y);
    *(uint2*)(q + 8) = make_uint2(g3.z, g3.w);
  }
  if constexpr (DQK == 96) {
    int key = t >> 2, c = t & 3;
    *(uint4*)(buf + key * KROW + 128 + c * 16) = g4;
  }
}

template <bool MASK>
DI void attn_half(f32x16& s, f32x16& sother, int T, const unsigned char* vb, bool domask, int kpc, int qpos, f32x16& negm,
                  float& lsum, f32x16 (&o)[2], int h, bool first) {
  if (MASK && domask) {
#pragma unroll
    for (int i = 0; i < 16; ++i) {
      int kk = kpc + 32 * T + (i & 3) + 8 * (i >> 2) + 4 * h;
      int d0 = qpos - kk;
      if (d0 > 128 || d0 < -128) s[i] = -1e30f;
    }
  }
  float mx = fmaxf(fmaxf(s[0], s[1]), s[2]);
#pragma unroll
  for (int i = 3; i < 15; i += 2) mx = fmaxf(fmaxf(mx, s[i]), s[i + 1]);
  mx = fmaxf(mx, s[15]);
  if (first || __builtin_amdgcn_ballot_w64(mx > 8.f) != 0ull) {
    mx = fmaxf(mx, __shfl_xor(mx, 32));
    float d = first ? mx : fmaxf(mx, 0.f);
    float alpha = first ? 1.f : __builtin_amdgcn_exp2f(-d);
    lsum *= alpha;
#pragma unroll
    for (int i = 0; i < 16; ++i) { o[0][i] *= alpha; o[1][i] *= alpha; s[i] -= d; negm[i] -= d; }
    if (T == 0) {
#pragma unroll
      for (int i = 0; i < 16; ++i) sother[i] -= d;
    }
  }
#pragma unroll
  for (int i = 0; i < 16; ++i) {
    s[i] = __builtin_amdgcn_exp2f(s[i]);
    lsum += s[i];
  }
#pragma unroll
  for (int st = 0; st < 2; ++st) {
    bf16x8 pb = MKFRAG(pk2(s[8 * st + 0], s[8 * st + 1]), pk2(s[8 * st + 2], s[8 * st + 3]),
                       pk2(s[8 * st + 4], s[8 * st + 5]), pk2(s[8 * st + 6], s[8 * st + 7]));
#pragma unroll
    for (int mt = 0; mt < 2; ++mt) {
      const unsigned char* vp = vb + (32 * mt) * VROW + (32 * T + 16 * st) * 2;
      uint2 lo = *(const uint2*)(vp);
      uint2 hi = *(const uint2*)(vp + 16);
      bf16x8 av = MKFRAG(lo.x, lo.y, hi.x, hi.y);
      o[mt] = MFMA(av, pb, o[mt]);
    }
  }
}

template <int DQK, bool MASK>
DI void attn_compute(const unsigned char* cur, const bf16x8 (&qf)[DQK / 16], bool domask, int kpc, int qpos, f32x16& negm,
                     float& lsum, f32x16 (&o)[2], int r, int h, bool first) {
  f32x16 s0 = negm, s1 = negm;
  __builtin_amdgcn_s_setprio(1);
#pragma unroll
  for (int ks = 0; ks < DQK / 16; ++ks) {
    bf16x8 a0 = *(const bf16x8*)(cur + r * KROW + (2 * ks + h) * 16);
    s0 = MFMA(a0, qf[ks], s0);
  }
#pragma unroll
  for (int ks = 0; ks < DQK / 16; ++ks) {
    bf16x8 a1 = *(const bf16x8*)(cur + (32 + r) * KROW + (2 * ks + h) * 16);
    s1 = MFMA(a1, qf[ks], s1);
  }
  __builtin_amdgcn_s_setprio(0);
  const unsigned char* vb = cur + 64 * KROW + r * VROW + 8 * h;
  attn_half<MASK>(s0, s1, 0, vb, domask, kpc, qpos, negm, lsum, o, h, first);
  attn_half<MASK>(s1, s0, 1, vb, domask, kpc, qpos, negm, lsum, o, h, false);
}

#define A_LOAD(S, IT)                                                                                     \
  {                                                                                                       \
    int itn_ = (IT);                                                                                      \
    int kp_ = wlo + (itn_ - 4) * 64;                                                                      \
    int krow0_ = (itn_ < 4) ? ctxrow0 + itn_ * 64 : latrow0 + kp_;                                        \
    int kcol0_ = (itn_ < 4) ? itn_ * 64 : LC + kp_;                                                       \
    attn_load<DQK>(ka, lda, kb, vt, krow0_, kcol0_, S##0, S##1, S##2, S##3, S##4);                        \
  }
template <int DQK, bool MASK>
DI void attn_block(const bf16_t* __restrict__ ka, int lda, const bf16_t* __restrict__ kb, const bf16_t* __restrict__ vt,
                   const bf16x8 (&qf)[DQK / 16], int ntiles, int ctxrow0, int latrow0, int wlo, int qpos,
                   float m_init, float l_init, f32x16 (&o)[2], float& l_out, unsigned char* smem) {
  const int lane = tidx() & 63;
  const int r = lane & 31, h = lane >> 5;
  uint4 ga0, ga1, ga2, ga3, ga4, gb0, gb1, gb2, gb3, gb4;
  const bool nofs = m_init < -1e29f;
  float lsum = l_init;
  f32x16 negm;
#pragma unroll
  for (int i = 0; i < 16; ++i) { o[0][i] = 0.f; o[1][i] = 0.f; negm[i] = nofs ? 0.f : -m_init; }
  A_LOAD(ga, 0);
  A_LOAD(gb, 1);
  __syncthreads();
  attn_store<DQK>(smem, ga0, ga1, ga2, ga3, ga4);
  if (ntiles > 2) A_LOAD(ga, 2);
  __syncthreads();
  for (int it = 0; it < ntiles; it += 2) {
    attn_compute<DQK, MASK>(smem, qf, it >= 4, wlo + (it - 4) * 64, qpos, negm, lsum, o, r, h, nofs && it == 0);
    attn_store<DQK>(smem + ATT_BUF, gb0, gb1, gb2, gb3, gb4);
    if (it + 3 < ntiles) A_LOAD(gb, it + 3);
    __syncthreads();
    attn_compute<DQK, MASK>(smem + ATT_BUF, qf, it + 1 >= 4, wlo + (it - 3) * 64, qpos, negm, lsum, o, r, h, false);
    if (it + 2 < ntiles) {
      attn_store<DQK>(smem, ga0, ga1, ga2, ga3, ga4);
      if (it + 4 < ntiles) A_LOAD(ga, it + 4);
    }
    __syncthreads();
  }
  l_out = lsum + __shfl_xor(lsum, 32);
}

DI void attn_finish(f32x16 (&o)[2], float l, bf16_t* grow  ) {
  const int lane = tidx() & 63;
  const int h = lane >> 5;
  float inv = 1.f / l;
  uint2 gv[2][4];
#pragma unroll
  for (int mt = 0; mt < 2; ++mt)
#pragma unroll
    for (int g = 0; g < 4; ++g) gv[mt][g] = *(const uint2*)(grow + 32 * mt + 8 * g + 4 * h);
#pragma unroll
  for (int mt = 0; mt < 2; ++mt)
#pragma unroll
    for (int g = 0; g < 4; ++g) {
      float y0 = o[mt][4 * g] * inv * bflo(gv[mt][g].x);
      float y1 = o[mt][4 * g + 1] * inv * bfhi(gv[mt][g].x);
      float y2 = o[mt][4 * g + 2] * inv * bflo(gv[mt][g].y);
      float y3 = o[mt][4 * g + 3] * inv * bfhi(gv[mt][g].y);
      uint2 ov = {pk2(y0, y1), pk2(y2, y3)};
      *(uint2*)(grow + 32 * mt + 8 * g + 4 * h) = ov;
    }
}

DI void mla_item(const P& p, int b, int hh, int qb, bool ctxq, unsigned char* smem, bool dry = false) {
  const bf16_t* QN = (const bf16_t*)(p.ws + OFF_QN);
  const bf16_t* QR = (const bf16_t*)(p.ws + OFF_QR);
  bf16_t* GT = (bf16_t*)(p.ws + OFF_GATE);
  const int lane = tidx() & 63, wave = tidx() >> 6;
  const int r = lane & 31, h = lane >> 5;
  const bf16_t* ka = (const bf16_t*)(p.ws + OFF_KN) + hh * 64;
  const bf16_t* kb = (const bf16_t*)(p.ws + OFF_KR);
  const bf16_t* vt = (const bf16_t*)(p.ws + OFF_VTM) + (size_t)(b * 8 + hh) * 64 * NKEY;
  int qrow = (ctxq ? R_LAT + b * LC : b * S_LAT) + qb * 128 + wave * 32 + r;
  bf16x8 qf[6];
#pragma unroll
  for (int ks = 0; ks < 4; ++ks) qf[ks] = *(const bf16x8*)(QN + (size_t)qrow * 512 + hh * 64 + ks * 16 + 8 * h);
#pragma unroll
  for (int ks = 0; ks < 2; ++ks) qf[4 + ks] = *(const bf16x8*)(QR + (size_t)qrow * 256 + hh * 32 + ks * 16 + 8 * h);
  const int ctxrow0 = R_LAT + b * LC, latrow0 = b * S_LAT;
  f32x16 o[2];
  float l;
  attn_block<96, false>(ka, 512, kb, vt, qf, ctxq ? 4 : NKEY / 64, ctxrow0, latrow0, 0, 0, -1e30f, 0.f, o, l, smem);
  if (!dry || p.phase_lo < 0) attn_finish(o, l, GT + (size_t)qrow * 1536 + 512 + hh * 64);
}

DI void swa_item(const P& p, int l_, int b, int hd, int qb, bool ctxq, unsigned char* smem, bool dry = false) {
  const bf16_t* SQ = (const bf16_t*)(p.ws + OFF_SQ);
  bf16_t* GT = (bf16_t*)(p.ws + OFF_GATE);
  const int lane = tidx() & 63, wave = tidx() >> 6;
  const int r = lane & 31, h = lane >> 5;
  const int g = hd >> 2;
  const bf16_t* ka = (const bf16_t*)(p.ws + OFF_SK) + g * 64;
  const bf16_t* vt = (const bf16_t*)(p.ws + OFF_SVT) + (size_t)(b * 2 + g) * 64 * NKEY;
  int qpos = qb * 128 + wave * 32 + r;
  int qrow = (ctxq ? R_LAT + b * LC : b * S_LAT) + qpos;
  bf16x8 qf[4];
#pragma unroll
  for (int ks = 0; ks < 4; ++ks) qf[ks] = *(const bf16x8*)(SQ + (size_t)qrow * 512 + hd * 64 + ks * 16 + 8 * h);
  const int ctxrow0 = R_LAT + b * LC, latrow0 = b * S_LAT;
  int wlo = (qb - 1) * 128; if (wlo < 0) wlo = 0;
  int whi = (qb + 2) * 128; if (whi > S_LAT) whi = S_LAT;
  int nt = ctxq ? 4 : 4 + (whi - wlo) / 64;
  float sk = p.sink[l_ * 8 + hd] * 1.4426950408889634f;
  f32x16 o[2];
  float l;
  attn_block<64, true>(ka, 128, nullptr, vt, qf, nt, ctxrow0, latrow0, wlo, qpos, sk, (h == 0) ? 1.f : 0.f, o, l, smem);
  if (!dry || p.phase_lo < 0) attn_finish(o, l, GT + (size_t)qrow * 1536 + 1024 + hd * 64);
}

DI void hyena_item(const P& p, int c, unsigned char* smem, bool dry = false) {
  const bf16_t* Fg = (const bf16_t*)(p.ws + OFF_FG) + (size_t)c * 16384;
  const bf16_t* UT = (const bf16_t*)(p.ws + OFF_UT) + (size_t)c * 16384;
  bf16_t* GT = (bf16_t*)(p.ws + OFF_GATE);
  const int t = tidx();
  const int lane = t & 63, wave = t >> 6;
  const int r = lane & 31, h = lane >> 5;
  const unsigned* F32 = (const unsigned*)smem;
  unsigned char* Ub = smem + 32768;
  __syncthreads();
#pragma unroll
  for (int i = 0; i < 8; ++i) {
    int idx = t + 256 * i;
    *(uint4*)(smem + idx * 16) = *(const uint4*)(Fg + idx * 8);
    int bb = idx >> 10, j = (idx >> 3) & 127, ch = idx & 7;
    uint4 v = *(const uint4*)(UT + idx * 8);
    *(uint4*)(Ub + bb * 16512 + j * 128 + ((ch ^ ((j >> 1) & 7)) << 4)) = v;
  }
  if (t < 16) *(uint4*)(Ub + (t >> 3) * 16512 + 128 * 128 + (t & 7) * 16) = make_uint4(0u, 0u, 0u, 0u);
  __syncthreads();
  const int ibase = 32 * wave;
  f32x16 acc[2][2];
  zero_acc(acc);
#define HY_FRAG(DST, Q)                                                                              \
  {                                                                                                  \
    int z0_ = 8192 - 16 * (Q) - r + 8 * h;                                                           \
    int dw_ = z0_ >> 1;                                                                              \
    unsigned x0_ = F32[dw_], x1_ = F32[dw_ + 1], x2_ = F32[dw_ + 2], x3_ = F32[dw_ + 3], x4_ = F32[dw_ + 4]; \
    DST = MKFRAG(__builtin_amdgcn_alignbit(x1_, x0_, sh), __builtin_amdgcn_alignbit(x2_, x1_, sh),    \
                 __builtin_amdgcn_alignbit(x3_, x2_, sh), __builtin_amdgcn_alignbit(x4_, x3_, sh));   \
  }
  const unsigned sh = (unsigned)((r & 1) * 16);
  bf16x8 f0, f1, f2, f3, f4, f5;
  {
    const int d0 = ibase - 127;
    HY_FRAG(f4, 4 * d0 - 3);
    HY_FRAG(f5, 4 * d0 - 2);
  }
#pragma unroll 1
  for (int d = ibase - 127; d <= ibase + 31; ++d) {
    f0 = f4; f1 = f5;
    HY_FRAG(f2, 4 * d - 1);
    HY_FRAG(f3, 4 * d);
    HY_FRAG(f4, 4 * d + 1);
    HY_FRAG(f5, 4 * d + 2);
    int j = ibase - d + r;
    int jc = ((unsigned)j < 128u) ? j : 128;
    const unsigned char* ub = Ub + jc * 128;
    const int sw = (jc >> 1) & 7;
#pragma unroll
    for (int bt = 0; bt < 2; ++bt) {
      const unsigned char* ubb = ub + bt * 16512;
      bf16x8 b0 = *(const bf16x8*)(ubb + (((0 + h) ^ sw) << 4));
      bf16x8 b1 = *(const bf16x8*)(ubb + (((2 + h) ^ sw) << 4));
      bf16x8 b2 = *(const bf16x8*)(ubb + (((4 + h) ^ sw) << 4));
      bf16x8 b3 = *(const bf16x8*)(ubb + (((6 + h) ^ sw) << 4));
      acc[0][bt] = MFMA(f3, b0, acc[0][bt]); acc[1][bt] = MFMA(f5, b0, acc[1][bt]);
      acc[0][bt] = MFMA(f2, b1, acc[0][bt]); acc[1][bt] = MFMA(f4, b1, acc[1][bt]);
      acc[0][bt] = MFMA(f1, b2, acc[0][bt]); acc[1][bt] = MFMA(f3, b2, acc[1][bt]);
      acc[0][bt] = MFMA(f0, b3, acc[0][bt]); acc[1][bt] = MFMA(f2, b3, acc[1][bt]);
    }
  }
  if (!dry || p.phase_lo < 0)
#pragma unroll
  for (int mi = 0; mi < 2; ++mi)
#pragma unroll
    for (int bt = 0; bt < 2; ++bt) {
      int i = ibase + r;
      bf16_t gvals[16];
#pragma unroll
      for (int reg = 0; reg < 16; ++reg) {
        int a2 = 32 * mi + (reg & 3) + 8 * (reg >> 2) + 4 * h;
        size_t grow = (size_t)bt * 8192 + 64 * i + a2;
        gvals[reg] = GT[grow * 1536 + c];
      }
#pragma unroll
      for (int reg = 0; reg < 16; ++reg) {
        int a2 = 32 * mi + (reg & 3) + 8 * (reg >> 2) + 4 * h;
        size_t grow = (size_t)bt * 8192 + 64 * i + a2;
        GT[grow * 1536 + c] = f2bf(bf2f(gvals[reg]) * acc[mi][bt][reg]);
      }
    }
}

DI void hyena_ctx_item(const P& p, int item) {
  const float* __restrict__ Fc = (const float*)(p.ws + OFF_FC);
  const float* __restrict__ UC = (const float*)(p.ws + OFF_UC);
  bf16_t* GT = (bf16_t*)(p.ws + OFF_GATE);
  const int t = tidx();
  int r0 = item * 8;
  int b = r0 >> 8, t0 = r0 & 255;
  for (int hc = 0; hc < 2; ++hc) {
    int c = hc * 256 + t;
    float acc[8], win[8];
#pragma unroll
    for (int i = 0; i < 8; ++i) { acc[i] = 0.f; win[i] = Fc[(size_t)(255 + t0 + i) * 512 + c]; }
#pragma unroll 8
    for (int s = 0; s < 256; ++s) {
      float u = UC[(size_t)(b * 256 + s) * 512 + c];
#pragma unroll
      for (int i = 0; i < 8; ++i) acc[i] += win[i] * u;
#pragma unroll
      for (int i = 7; i > 0; --i) win[i] = win[i - 1];
      int nidx = 255 + t0 - s - 1;
      win[0] = (nidx >= 0) ? Fc[(size_t)nidx * 512 + c] : 0.f;
    }
#pragma unroll
    for (int i = 0; i < 8; ++i) {
      bf16_t* q = GT + (size_t)(R_LAT + r0 + i) * 1536 + c;
      *q = f2bf(bf2f(*q) * acc[i]);
    }
  }
}

DI void phase_mixers(const P& p, int l, unsigned char* smem, int* s_item) {
  unsigned* ctr = (unsigned*)(p.ws + OFF_CTR) + l;
  const int n_mla = 1024, n_hy = 512, n_swa = 1024;
  const int n_cm = (l == 0) ? 32 : 0, n_cs = (l == 0) ? 32 : 0, n_ch = (l == 0) ? 64 : 0;
  const int c0 = n_ch, c1 = c0 + n_cm, c2 = c1 + n_cs;
  const int e0 = c2 + n_mla, e1 = e0 + n_hy, e2 = e1 + n_swa;
  for (;;) {
    __syncthreads();
    if (tidx() == 0) *s_item = (int)atomicAdd(ctr, 1u);
    __syncthreads();
    int item = *s_item;
    if (item >= e2) break;
    if (item < c0) {
      hyena_ctx_item(p, item);
    } else if (item < c1) {
      int it = item - c0;
      mla_item(p, it >> 4, (it >> 1) & 7, it & 1, true, smem);
    } else if (item < c2) {
      int it = item - c1;
      swa_item(p, l, it >> 4, (it >> 1) & 7, it & 1, true, smem);
    } else if (item < e0) {
      int it = item - c2;
      mla_item(p, it >> 9, (it >> 6) & 7, it & 63, false, smem);
    } else if (item < e1) {
      hyena_item(p, item - e0, smem);
    } else {
      int it = item - e1;
      swa_item(p, l, it >> 9, (it >> 6) & 7, it & 63, false, smem);
    }
  }
}

DI void phase_mixers_dry(const P& p, int l, unsigned char* smem, int kind) {
  if (kind == 1) {
    for (int item = blockIdx.x; item < 1024; item += gridDim.x) mla_item(p, item >> 9, (item >> 6) & 7, item & 63, false, smem, true);
  } else if (kind == 2) {
    for (int item = blockIdx.x; item < 512; item += gridDim.x) hyena_item(p, item, smem, true);
  } else {
    for (int item = blockIdx.x; item < 1024; item += gridDim.x) swa_item(p, l, item >> 9, (item >> 6) & 7, item & 63, false, smem, true);
  }
}

DI void phase_merge(const P& p, int l, unsigned char* smem) {
  const bf16_t* U = (const bf16_t*)(p.ws + OFF_U);
  const bf16_t* Wmg = (const bf16_t*)(p.ws + OFF_W + WOFF_IN) + (size_t)N1 * 1024;
  const bf16_t* Wp = (const bf16_t*)(p.ws + OFF_W + WOFF_P);
  const bf16_t* Y = (const bf16_t*)(p.ws + OFF_GATE);
  bf16_t* M = (bf16_t*)(p.ws + OFF_M);
  const int lane = tidx() & 63, wave = tidx() >> 6;
  const int r = lane & 31, h = lane >> 5, wn = wave & 1, wm = wave >> 1;
  const int nm = (l == 0) ? R_ALL / 128 : R_LAT / 128;
  const int spx = gridDim.x >> 3;
  const int xcd = blockIdx.x & 7, slot = blockIdx.x >> 3;
  const int pair = xcd & 3, mhalf = xcd >> 2, nmh = (R_LAT / 128) >> 1;
  const bf16_t* SGC = (const bf16_t*)(p.ws + OFF_SGC);
  const int nctx = (l == 0) ? 4 : 0;
  const int nlat = nmh * 2;
  for (int k = 0; k * spx < nlat + nctx + spx - 1; ++k) {
    int j = k * spx + slot;
    int jj = j;
    bool isc = false;
    if (jj >= nlat) {
      int base = ((nlat + spx - 1) / spx) * spx;
      if (j < base || j >= base + nctx) continue;
      jj = j - base;
      isc = true;
    }
    int mtile, ntile;
    if (!isc) { mtile = mhalf * nmh + (jj >> 1); ntile = 2 * pair + (jj & 1); }
    else { mtile = R_LAT / 128 + 2 * mhalf + (jj >> 1); ntile = 2 * pair + (jj & 1); }
    unsigned msum[2][2][8];
#pragma unroll
    for (int i = 0; i < 2; ++i)
#pragma unroll
      for (int j = 0; j < 2; ++j)
#pragma unroll
        for (int k = 0; k < 8; ++k) msum[i][j][k] = 0u;
#pragma unroll 1
    for (int br = 0; br < 3; ++br) {
      f32x16 acc[2][2];
      unsigned sg[2][2][8];
      if (!isc) {
        zero_acc(acc);
        gemm_core(Wmg + (size_t)(br * 1024 + ntile * 128) * 1024, 1024, U + (size_t)mtile * 128 * 1024, 1024, 1024, acc, smem);
#pragma unroll
        for (int i = 0; i < 2; ++i)
#pragma unroll
          for (int j = 0; j < 2; ++j)
#pragma unroll
            for (int k = 0; k < 8; ++k) sg[i][j][k] = pk2(sigm_f(acc[i][j][2 * k]), sigm_f(acc[i][j][2 * k + 1]));
      } else {
#pragma unroll
        for (int i = 0; i < 2; ++i)
#pragma unroll
          for (int j = 0; j < 2; ++j) {
            int mrow = mtile * 128 + wm * 64 + j * 32 + r - R_LAT;
            const bf16_t* gp = SGC + (size_t)mrow * 3072 + br * 1024 + ntile * 128 + wn * 64 + i * 32 + 4 * h;
#pragma unroll
            for (int g = 0; g < 4; ++g) {
              uint2 v = *(const uint2*)(gp + 8 * g);
              sg[i][j][2 * g] = v.x;
              sg[i][j][2 * g + 1] = v.y;
            }
          }
      }
      zero_acc(acc);
      gemm_core(Wp + (size_t)(br * 1024 + ntile * 128) * 512, 512, Y + (size_t)mtile * 128 * 1536 + br * 512, 1536, 512, acc, smem);
#pragma unroll
      for (int i = 0; i < 2; ++i)
#pragma unroll
        for (int j = 0; j < 2; ++j)
#pragma unroll
          for (int k = 0; k < 8; ++k) {
            float lo = bflo(msum[i][j][k]) + bflo(sg[i][j][k]) * acc[i][j][2 * k];
            float hi = bfhi(msum[i][j][k]) + bfhi(sg[i][j][k]) * acc[i][j][2 * k + 1];
            msum[i][j][k] = pk2(lo, hi);
          }
    }
#pragma unroll
    for (int mt = 0; mt < 2; ++mt) {
      int m = mtile * 128 + wm * 64 + mt * 32 + r;
#pragma unroll
      for (int nt = 0; nt < 2; ++nt) {
        int n = ntile * 128 + wn * 64 + nt * 32 + 4 * h;
#pragma unroll
        for (int g = 0; g < 4; ++g) {
          uint2 o = {msum[nt][mt][2 * g], msum[nt][mt][2 * g + 1]};
          *(uint2*)(M + (size_t)m * 1024 + n + 8 * g) = o;
        }
      }
    }
  }
}

DI void phase_out(const P& p, int l, unsigned char* smem) {
  const bf16_t* M = (const bf16_t*)(p.ws + OFF_M);
  const bf16_t* Wo = (const bf16_t*)(p.ws + OFF_W + WOFF_OUT);
  const float* mod = (const float*)(p.ws + OFF_MOD) + (size_t)l * 3 * 3072;
  float* zc = (float*)(p.ws + OFF_ZC);
  const int lane = tidx() & 63, wave = tidx() >> 6;
  const int r = lane & 31, h = lane >> 5, wn = wave & 1, wm = wave >> 1;
  const int nm = (l == 0) ? R_ALL / 128 : R_LAT / 128;
  const float ALPHA = 1.4142135623730951f;
  for (int k = 0; k * (int)gridDim.x < nm * 8; ++k) {
    int item = xcd_item(k);
    if (item >= nm * 8) continue;
    int mtile = item >> 3, ntile = item & 7;
    f32x16 acc[2][2];
    zero_acc(acc);
    gemm_core<true>(Wo + (size_t)ntile * 128 * 1024, 1024, M + (size_t)mtile * 128 * 1024, 1024, 1024, acc, smem);
#pragma unroll
    for (int mt = 0; mt < 2; ++mt) {
      int m = mtile * 128 + wm * 64 + mt * 32 + r;
      const float* xin;
      float* dst;
      int v;
      if (m < R_LAT) {
        xin = (l == 0 ? p.x : p.out) + (size_t)m * 1024;
        dst = p.out + (size_t)m * 1024;
        v = m >> 13;
      } else {
        xin = p.ctx + (size_t)(m - R_LAT) * 1024;
        dst = zc + (size_t)(m - R_LAT) * 1024;
        v = 2;
      }
      const float* gate = mod + (size_t)v * 3072 + 2048;
#pragma unroll
      for (int nt = 0; nt < 2; ++nt) {
        int n = ntile * 128 + wn * 64 + nt * 32 + 4 * h;
#pragma unroll
        for (int g = 0; g < 4; ++g) {
          f32x16& a = acc[nt][mt];
          float4 xv = *(const float4*)(xin + n + 8 * g);
          float4 gv = *(const float4*)(gate + n + 8 * g);
          float4 o;
          o.x = ALPHA * xv.x + gv.x * a[4 * g];
          o.y = ALPHA * xv.y + gv.y * a[4 * g + 1];
          o.z = ALPHA * xv.z + gv.z * a[4 * g + 2];
          o.w = ALPHA * xv.w + gv.w * a[4 * g + 3];
          *(float4*)(dst + n + 8 * g) = o;
        }
      }
    }
  }
}

DI void phase_prep(const P& p, int l, unsigned char* smem) {
  if (blockIdx.x == 0 && tidx() == 0) ((unsigned*)(p.ws + OFF_CTR))[l] = 0u;
  const int nlat = S_LAT / 16, nctx = (l == 0) ? LC / 16 : 0;
  for (int item = blockIdx.x; item < nlat; item += gridDim.x) filter_item(p, l, S_LAT, item * 16, false, smem);
  for (int item = (int)gridDim.x - 1 - (int)blockIdx.x; item < nctx; item += gridDim.x) filter_item(p, l, LC, item * 16, true, smem);
  phase_convert(p, l, smem);
}

constexpr int NPHASE = 17;

__global__ void __launch_bounds__(256, 2) mega(P p) {
  __shared__ __attribute__((aligned(16))) unsigned char smem[73728];
  __shared__ float rs[128];
  __shared__ int s_item;
  cg::grid_group grid = cg::this_grid();
  if (p.phase_lo < 0) grid.sync();
  __shared__ uint4 xb_words;
  if (threadIdx.x == 0) xb_words = make_uint4(0u, 0u, 0u, 0u);
  __syncthreads();
  XcdBarrier xb = xcd_barrier_post((unsigned*)(p.ws + OFF_BAR), (volatile LAS unsigned*)&xb_words);
  for (int ph = p.phase_lo; ph < p.phase_hi; ++ph) {
#ifndef PH_MASK
#define PH_MASK 0x1ff
#endif
    if (ph == 0) {
      if (PH_MASK & 0x100) {
        phase_mod(p, smem);
        phase_prep(p, 0, smem);
        if (tidx() == 0) {
          unsigned* cp = (unsigned*)(p.ws + OFF_CTR) + 16;
          unsigned spins = 0;
          while (__hip_atomic_load(cp, __ATOMIC_RELAXED, __HIP_MEMORY_SCOPE_AGENT) < 192u && ++spins < (1u << 24)) __builtin_amdgcn_s_sleep(2);
          __builtin_amdgcn_fence(__ATOMIC_ACQUIRE, "agent");
          asm volatile("s_waitcnt vmcnt(0)" ::: "memory");
        }
        __syncthreads();
        phase_ln0(p);
      }
    } else {
      int l = (ph - 1) >> 3, sub = (ph - 1) & 7;
      switch (sub) {
#ifndef EXP
#define EXP 0
#endif
        case 0: break;
        case 1: if (PH_MASK & 2) { phase_gemm1(p, l, smem); } break;
        case 2: if (PH_MASK & 4) { phase_hyprep(p, l, smem);  } break;
        case 3: if (PH_MASK & 8) { phase_upproj(p, l, smem, rs); } break;
        case 4: if (PH_MASK & 16) { phase_mixers(p, l, smem, &s_item); } break;
        case 5: if (PH_MASK & 32) { phase_merge(p, l, smem); } break;
        case 6: if (PH_MASK & 64) { phase_out(p, l, smem); } break;
        case 7: if (PH_MASK & 128) { phase_lnG(p, l); if (l == 0) phase_prep(p, 1, smem); } break;
      }
    }
    if (ph + 1 < p.phase_hi && ph != 9 && ph != 1) { xcd_barrier(xb); }
  }
}

extern "C" void kernel_launch(void* const* d_in, const int* in_sizes, int n_in, void* d_out, int out_size, void* d_ws,
                              size_t ws_size, hipStream_t stream) {
  static int grid_blocks = 0;
  if (!grid_blocks) {
    int dev = 0, cus = 0, per_cu = 0;
    hipGetDevice(&dev);
    hipDeviceGetAttribute(&cus, hipDeviceAttributeMultiprocessorCount, dev);
    hipOccupancyMaxActiveBlocksPerMultiprocessor(&per_cu, mega, 256, 0);
    if (per_cu < 1) per_cu = 1;
    if (per_cu > 2) per_cu = 2;
    grid_blocks = cus * per_cu;
  }
  P p;
  memset(&p, 0, sizeof(p));
  const float** f = (const float**)&p;
  for (int i = 0; i < 29; ++i) f[i] = (const float*)d_in[i];
  p.out = (float*)d_out;
  p.ws = (char*)d_ws;
#if MULTI_LAUNCH
  for (int ph = 0; ph < NPHASE; ++ph) {
    p.phase_lo = ph;
    p.phase_hi = ph + 1;
    hipLaunchKernelGGL(mega, dim3(grid_blocks), dim3(256), 0, stream, p);
  }
#else
  p.phase_lo = 0;
  p.phase_hi = NPHASE;
  hipMemsetAsync((char*)d_ws + OFF_CTR, 0, 256 + 16384, stream);
  void* args[] = {&p};
  hipError_t e = hipLaunchCooperativeKernel((void*)mega, dim3(grid_blocks), dim3(256), args, 0, stream);
  if (e != hipSuccess) fprintf(stderr, "cooperative launch failed: %s (grid %d)\n", hipGetErrorString(e), grid_blocks);
#endif
}
```

```cpp
#include <hip/hip_runtime.h>
#include <hip/hip_cooperative_groups.h>
#include <stdint.h>
#include <stdio.h>
#include <string.h>
namespace cg = cooperative_groups;

#ifndef MULTI_LAUNCH
#define MULTI_LAUNCH 0
#endif

typedef __attribute__((ext_vector_type(8))) short bf16x8;
typedef __attribute__((ext_vector_type(16))) float f32x16;
typedef unsigned short bf16_t;
typedef __attribute__((ext_vector_type(4))) unsigned u32x4;
#define MKFRAG(a, b, c, d) __builtin_bit_cast(bf16x8, (u32x4){(a), (b), (c), (d)})
#define DI __device__ __forceinline__
#define MFMA(a, b, c) __builtin_amdgcn_mfma_f32_32x32x16_bf16((a), (b), (c), 0, 0, 0)

constexpr int S_LAT = 8192, LC = 256, DM = 1024;
constexpr int R_LAT = 16384, R_CTX = 512, R_ALL = 16896;
constexpr int NKEY = 8448;
constexpr int N1 = 4352;
constexpr int NWIN = 7424;
constexpr int P_TOTAL = 7328;

constexpr size_t SZ_U = (size_t)R_ALL * 1024 * 2;
constexpr size_t SZ_HY = (size_t)R_ALL * 1536 * 2;
constexpr size_t OFF_U = 0;
constexpr size_t OFF_HY = OFF_U + SZ_U;
constexpr size_t OFF_QN = OFF_HY;
constexpr size_t OFF_QR = OFF_QN + (size_t)R_ALL * 512 * 2;
constexpr size_t OFF_KN = OFF_QR + (size_t)R_ALL * 256 * 2;
constexpr size_t OFF_M = OFF_HY;
constexpr size_t OFF_GATE = OFF_HY + SZ_HY;
constexpr size_t OFF_CQ = OFF_GATE + SZ_HY;
constexpr size_t OFF_CKV = OFF_CQ + (size_t)R_ALL * 256 * 2;
constexpr size_t OFF_KR = OFF_CKV + (size_t)R_ALL * 128 * 2;
constexpr size_t OFF_SQ = OFF_KR + (size_t)R_ALL * 32 * 2;
constexpr size_t OFF_SK = OFF_SQ + (size_t)R_ALL * 512 * 2;
constexpr size_t OFF_SVT = OFF_SK + (size_t)R_ALL * 128 * 2;
constexpr size_t OFF_VTM = OFF_SVT + (size_t)2 * 2 * 64 * NKEY * 2;
constexpr size_t OFF_UT = OFF_VTM + (size_t)2 * 8 * 64 * NKEY * 2;
constexpr size_t OFF_UC = OFF_UT + (size_t)512 * 16384 * 2;
constexpr size_t OFF_W = OFF_UC + (size_t)512 * 512 * 4;
constexpr size_t WOFF_IN = 0;
constexpr size_t WOFF_UQ = WOFF_IN + (size_t)NWIN * 1024 * 2;
constexpr size_t WOFF_UKV = WOFF_UQ + (size_t)768 * 256 * 2;
constexpr size_t WOFF_P = WOFF_UKV + (size_t)1024 * 128 * 2;
constexpr size_t WOFF_OUT = WOFF_P + (size_t)3 * 1024 * 512 * 2;
constexpr size_t SZ_W = WOFF_OUT + (size_t)1024 * 1024 * 2;
constexpr size_t OFF_FG = OFF_W + SZ_W;
constexpr size_t OFF_FC = OFF_FG + (size_t)512 * 16384 * 2;
constexpr size_t OFF_MOD = OFF_FC + (size_t)512 * 512 * 4;
constexpr size_t OFF_ZC = OFF_MOD + (size_t)2 * 3 * 3072 * 4;
constexpr size_t OFF_CTR = OFF_ZC + (size_t)512 * 1024 * 4;
constexpr size_t OFF_BAR = OFF_CTR + 256;
constexpr size_t OFF_SGC = OFF_BAR + 16384;
constexpr size_t WS_TOTAL = OFF_SGC + (size_t)R_CTX * 3072 * 2;
static_assert(WS_TOTAL <= (size_t)256 * 1024 * 1024, "workspace too large");
static_assert(OFF_KN + (size_t)R_ALL * 512 * 2 <= OFF_GATE, "alias overflow");

struct P {
  const float *x, *c, *ctx, *c_ctx, *w_ada, *b_ada, *w_in, *hy_conv_w, *hy_conv_b;
  const float *fw1, *fb1, *fw2, *fb2, *fw3, *fb3, *ffreq, *fwout, *hy_skip;
  const float *q_norm, *w_uq, *kv_norm, *w_ukv, *sink, *wp_hy, *wp_mla, *wp_swa, *w_out, *ln_g, *ln_b;
  float* out;
  char* ws;
  int phase_lo, phase_hi;
};

DI int tidx() { int t = __builtin_amdgcn_workitem_id_x(); asm volatile("" : "+v"(t)); return t; }
DI float bf2f(unsigned short v) { return __uint_as_float(((unsigned)v) << 16); }
DI float bflo(unsigned v) { return __uint_as_float(v << 16); }
DI float bfhi(unsigned v) { return __uint_as_float(v & 0xffff0000u); }
typedef float f32x2_t __attribute__((ext_vector_type(2)));
typedef __bf16 bf16x2_t __attribute__((ext_vector_type(2)));
DI unsigned pk2(float lo, float hi) {
  f32x2_t v = {lo, hi};
  bf16x2_t b = __builtin_convertvector(v, bf16x2_t);
  return __builtin_bit_cast(unsigned, b);
}
DI unsigned short f2bf(float v) { return (unsigned short)(pk2(v, 0.f) & 0xffffu); }
DI float silu_f(float v) { return v / (1.f + __expf(-v)); }
DI float sigm_f(float v) { return 1.f / (1.f + __expf(-v)); }
DI float wave_sum(float v) {
#pragma unroll
  for (int o = 32; o >= 1; o >>= 1) v += __shfl_xor(v, o);
  return v;
}

#define GL1(V, PTR, LD, KT, P) V = *(const uint4*)((PTR) + (size_t)(rw + 32 * (P)) * (LD) + (KT) * 64 + c8 * 8)
#define G_LOAD(S, KT)                                                                     \
  GL1(S##w0, Wt, ldw, KT, 0); GL1(S##w1, Wt, ldw, KT, 1); GL1(S##w2, Wt, ldw, KT, 2); GL1(S##w3, Wt, ldw, KT, 3); \
  GL1(S##x0, X, ldx, KT, 0);  GL1(S##x1, X, ldx, KT, 1);  GL1(S##x2, X, ldx, KT, 2);  GL1(S##x3, X, ldx, KT, 3)
#define GS1(V, BASE, P) *(uint4*)((BASE) + (rw + 32 * (P)) * 72 + (c8 << 3)) = V
#define G_STORE(S, BUF)                                                                   \
  GS1(S##w0, sW + (BUF) * 9216, 0); GS1(S##w1, sW + (BUF) * 9216, 1); GS1(S##w2, sW + (BUF) * 9216, 2); GS1(S##w3, sW + (BUF) * 9216, 3); \
  GS1(S##x0, sX + (BUF) * 9216, 0); GS1(S##x1, sX + (BUF) * 9216, 1); GS1(S##x2, sX + (BUF) * 9216, 2); GS1(S##x3, sX + (BUF) * 9216, 3)
DI void g_compute(const bf16_t* cw, const bf16_t* cx, f32x16 (&acc)[2][2]) {
  __builtin_amdgcn_s_setprio(1);
#pragma unroll
  for (int ks = 0; ks < 4; ++ks) {
    bf16x8 a[2], b[2];
#pragma unroll
    for (int i = 0; i < 2; ++i) {
      a[i] = *(const bf16x8*)(cw + i * 32 * 72 + ks * 16);
      b[i] = *(const bf16x8*)(cx + i * 32 * 72 + ks * 16);
    }
#pragma unroll
    for (int i = 0; i < 2; ++i)
#pragma unroll
      for (int j = 0; j < 2; ++j) acc[i][j] = MFMA(a[i], b[j], acc[i][j]);
  }
  __builtin_amdgcn_s_setprio(0);
}

template <bool TWO = false>
DI void gemm_core(const bf16_t* __restrict__ Wt, int ldw, const bf16_t* __restrict__ X, int ldx, int K,
                  f32x16 (&acc)[2][2], unsigned char* smem) {
  const int tid = tidx();
  const int lane = tid & 63, wave = tid >> 6;
  const int r = lane & 31, h = lane >> 5;
  const int wn = wave & 1, wm = wave >> 1;
  const int c8 = tid & 7, rw = tid >> 3;
  bf16_t* sW = (bf16_t*)smem;
  bf16_t* sX = (bf16_t*)(smem + 36864);
  const bf16_t* cw = sW + (wn * 64 + r) * 72 + h * 8;
  const bf16_t* cx = sX + (wm * 64 + r) * 72 + h * 8;
  if constexpr (TWO) {
  uint4 ew0, ew1, ew2, ew3, ex0, ex1, ex2, ex3, ow0, ow1, ow2, ow3, ox0, ox1, ox2, ox3;
  const int nk = K >> 6;
  G_LOAD(e, 0);
  G_LOAD(o, 1);
  __syncthreads();
  G_STORE(e, 0);
  if (nk > 2) { G_LOAD(e, 2); }
  __syncthreads();
  for (int kt = 0; kt < nk; kt += 2) {
    g_compute(cw, cx, acc);
    G_STORE(o, 1);
    if (kt + 3 < nk) { G_LOAD(o, kt + 3); }
    __syncthreads();
    g_compute(cw + 9216, cx + 9216, acc);
    if (kt + 2 < nk) {
      G_STORE(e, 0);
      if (kt + 4 < nk) { G_LOAD(e, kt + 4); }
    }
    __syncthreads();
  }
  } else {
  uint4 ew0, ew1, ew2, ew3, ex0, ex1, ex2, ex3;
  const int nk = K >> 6;
  {
    uint4 ow0, ow1, ow2, ow3, ox0, ox1, ox2, ox3;
    G_LOAD(e, 0);
    G_LOAD(o, 1);
    __syncthreads();
    G_STORE(e, 0);
    if (nk > 2) { G_LOAD(e, 2); }
    __syncthreads();
    G_STORE(o, 1);
    g_compute(cw, cx, acc);
    __syncthreads();
  }
#pragma unroll 1
  for (int kt = 1; kt < nk; ++kt) {
    const int cur = kt & 1;
    if (kt + 1 < nk) { G_STORE(e, cur ^ 1); }
    if (kt + 2 < nk) { G_LOAD(e, kt + 2); }
    g_compute(cw + cur * 9216, cx + cur * 9216, acc);
    __syncthreads();
  }
  }
}

DI void zero_acc(f32x16 (&acc)[2][2]) {
#pragma unroll
  for (int i = 0; i < 2; ++i)
#pragma unroll
    for (int j = 0; j < 2; ++j)
#pragma unroll
      for (int k = 0; k < 16; ++k) acc[i][j][k] = 0.f;
}

#define XB_TMO      128
#define XB_XCNT(j)  (256  + 64 * (j))
#define XB_XSUB(j)  (1280 + 64 * (j))
#define XB_XGEN(j)  (2304 + 64 * (j))
#define XB_TOP      3328
#define XB_TOPGEN   3392
#define XCD_BAR_WORDS 3456
#define XB_SPIN_CAP (1u << 18)
#define LAS __attribute__((address_space(3)))

__device__ __forceinline__ unsigned xb_ld(unsigned* p)              { return __hip_atomic_load(p, __ATOMIC_RELAXED, __HIP_MEMORY_SCOPE_AGENT); }
__device__ __forceinline__ unsigned xb_add(unsigned* p, unsigned v) { return __hip_atomic_fetch_add(p, v, __ATOMIC_RELAXED, __HIP_MEMORY_SCOPE_AGENT); }
__device__ __forceinline__ unsigned xb_xcc_id() { return (unsigned)__builtin_amdgcn_s_getreg((3 << 11) | 20) & 0xFu; }
#define XB_SPIN(cond, bar) do { unsigned _sp = 0; while (cond) { __builtin_amdgcn_s_sleep(1); \
    if ((++_sp & 255u) == 0u) { if (xb_ld(&(bar)[XB_TMO])) break; if (_sp > XB_SPIN_CAP) { atomicAdd(&(bar)[XB_TMO], 1u); break; } } } } while (0)

struct XcdBarrier {
    unsigned* bar; unsigned x;
    volatile LAS unsigned* st;
};

__device__ __forceinline__ XcdBarrier xcd_barrier_post(unsigned* bar, volatile LAS unsigned* st) {
    XcdBarrier b; b.bar = bar; b.x = xb_xcc_id(); b.st = st;
    if (threadIdx.x == 0) (void)xb_add(&bar[XB_XCNT(b.x)], 1u);
    return b;
}
__device__ __forceinline__ void xcd_barrier_complete(unsigned* bar, unsigned x, unsigned& nloc, unsigned& nx) {
    const unsigned G = gridDim.x * gridDim.y * gridDim.z;
    unsigned sum, cnt, mine, sp = 0u;
    for (;;) {
        sum = 0u; cnt = 0u; mine = 0u;
#pragma unroll
        for (unsigned j = 0; j < 16; ++j) { const unsigned c = xb_ld(&bar[XB_XCNT(j)]); sum += c; cnt += (c > 0u) ? 1u : 0u; mine = (j == x) ? c : mine; }
        if (sum == G) break;
        __builtin_amdgcn_s_sleep(1);
        if ((++sp & 255u) == 0u) { if (xb_ld(&bar[XB_TMO])) break; if (sp > XB_SPIN_CAP) { atomicAdd(&bar[XB_TMO], 1u); break; } }
    }
    nloc = mine > 0u ? mine : 1u; nx = cnt > 0u ? cnt : 1u;
}

__device__ __forceinline__ void xcd_barrier(const XcdBarrier& b) {
    asm volatile("s_waitcnt vmcnt(0)" ::: "memory");
    __syncthreads();
    if (threadIdx.x == 0) {
        unsigned* bar = b.bar;
        __builtin_amdgcn_s_waitcnt(0);
        unsigned nloc = b.st[0], nx = b.st[1];
        if (nloc == 0u) { xcd_barrier_complete(bar, b.x, nloc, nx); b.st[0] = nloc; b.st[1] = nx; }
        const unsigned old = xb_add(&bar[XB_XSUB(b.x)], 1u);
        const unsigned gen = old / nloc;
        if (old + 1u == (gen + 1u) * nloc) {
            __builtin_amdgcn_fence(__ATOMIC_RELEASE, "agent");
            asm volatile("s_waitcnt vmcnt(0)" ::: "memory");
            const unsigned og = xb_add(&bar[XB_TOP], 1u);
            const unsigned tg = og / nx;
            if (og + 1u == (tg + 1u) * nx) xb_add(&bar[XB_TOPGEN], 1u);
            else XB_SPIN(xb_ld(&bar[XB_TOPGEN]) == tg, bar);
            __builtin_amdgcn_fence(__ATOMIC_ACQUIRE, "agent");
            xb_add(&bar[XB_XGEN(b.x)], 1u);
            asm volatile("s_waitcnt vmcnt(0)" ::: "memory");
        } else {
            XB_SPIN(xb_ld(&bar[XB_XGEN(b.x)]) == gen, bar);
            __builtin_amdgcn_fence(__ATOMIC_ACQUIRE, "agent");
            asm volatile("s_waitcnt vmcnt(0)" ::: "memory");
        }
    }
    __syncthreads();
}


DI void grid_bar(unsigned* bar, unsigned target) {
  __syncthreads();
  if (tidx() == 0) {
    __threadfence();
    __hip_atomic_fetch_add(bar, 1u, __ATOMIC_RELAXED, __HIP_MEMORY_SCOPE_AGENT);
    while (__hip_atomic_load(bar, __ATOMIC_RELAXED, __HIP_MEMORY_SCOPE_AGENT) < target) __builtin_amdgcn_s_sleep(1);
    __threadfence();
  }
  __syncthreads();
}
DI int xcd_item(int k) {
  int nb = gridDim.x, b = blockIdx.x;
  return k * nb + (b & 7) * (nb >> 3) + (b >> 3);
}

struct RowInfo { int isctx, b, prow, pcol, kidx; };
DI RowInfo row_info(int m) {
  RowInfo ri;
  if (m < R_LAT) {
    int t = m & (S_LAT - 1);
    ri.isctx = 0; ri.b = m >> 13; ri.prow = t >> 6; ri.pcol = t & 63; ri.kidx = LC + t;
  } else {
    int i = m - R_LAT;
    ri.isctx = 1; ri.b = i >> 8; ri.prow = 0; ri.pcol = 0; ri.kidx = i & 255;
  }
  return ri;
}

DI void phase_mod(const P& p, unsigned char* smem) {
  float* red = (float*)smem;
  float* sc = (float*)(smem + 4096);
  float* mod = (float*)(p.ws + OFF_MOD);
  const int t = tidx();
  if (blockIdx.x < 192) {
    for (int i = t; i < 3072; i += 256) {
      float v = (i < 2048) ? p.c[i] : p.c_ctx[i - 2048];
      sc[i] = silu_f(v);
    }
    __syncthreads();
  }
  for (int item = blockIdx.x; item < 192; item += gridDim.x) {
    int l = item / 96, j0 = (item % 96) * 32;
    int col = j0 + (t & 31), kq = t >> 5;
    const float* w = p.w_ada + (size_t)l * 1024 * 3072;
    float a0 = 0.f, a1 = 0.f, a2 = 0.f;
#pragma unroll 1
    for (int k0 = kq * 128; k0 < kq * 128 + 128; k0 += 32) {
      float wr[32];
#pragma unroll
      for (int k = 0; k < 32; ++k) wr[k] = w[(size_t)(k0 + k) * 3072 + col];
#pragma unroll
      for (int k = 0; k < 32; ++k) {
        a0 += sc[k0 + k] * wr[k];
        a1 += sc[1024 + k0 + k] * wr[k];
        a2 += sc[2048 + k0 + k] * wr[k];
      }
    }
    __syncthreads();
    red[(0 * 8 + kq) * 32 + (t & 31)] = a0;
    red[(1 * 8 + kq) * 32 + (t & 31)] = a1;
    red[(2 * 8 + kq) * 32 + (t & 31)] = a2;
    __syncthreads();
    if (t < 96) {
      int v = t >> 5, cc = t & 31;
      float s = 0.f;
#pragma unroll
      for (int q = 0; q < 8; ++q) s += red[(v * 8 + q) * 32 + cc];
      mod[(size_t)(l * 3 + v) * 3072 + j0 + cc] = s + p.b_ada[(size_t)l * 3072 + j0 + cc];
    }
  }
}

DI void convert_tile(const float* __restrict__ src, int ldsrc, int c0, int ncols, int K, bf16_t* __restrict__ dst,
                     const float* __restrict__ kscale, int it, unsigned char* smem) {
  float* tile = (float*)smem;
  const int t = tidx();
  const int tx = t & 15, ty = t >> 4;
  const int wn = t >> 2, wk = (t & 3) * 16;
  const int tk = K >> 6;
  int k0 = (it % tk) * 64, n0 = (it / tk) * 64;
  float4 v[4];
  bool okl = (n0 + 4 * tx) < ncols;
#pragma unroll
  for (int i = 0; i < 4; ++i) {
    int kk = ty + 16 * i;
    v[i] = okl ? *(const float4*)(src + (size_t)(k0 + kk) * ldsrc + c0 + n0 + 4 * tx) : make_float4(0.f, 0.f, 0.f, 0.f);
    if (kscale) { float sc = kscale[k0 + kk]; v[i].x *= sc; v[i].y *= sc; v[i].z *= sc; v[i].w *= sc; }
  }
  __syncthreads();
#pragma unroll
  for (int i = 0; i < 4; ++i) {
    int kk = ty + 16 * i;
    tile[kk * 65 + 4 * tx + 0] = v[i].x;
    tile[kk * 65 + 4 * tx + 1] = v[i].y;
    tile[kk * 65 + 4 * tx + 2] = v[i].z;
    tile[kk * 65 + 4 * tx + 3] = v[i].w;
  }
  __syncthreads();
  if (n0 + wn < ncols) {
    unsigned o[8];
#pragma unroll
    for (int j = 0; j < 8; ++j) o[j] = pk2(tile[(wk + 2 * j) * 65 + wn], tile[(wk + 2 * j + 1) * 65 + wn]);
    uint4* d = (uint4*)(dst + (size_t)(n0 + wn) * K + k0 + wk);
    d[0] = make_uint4(o[0], o[1], o[2], o[3]);
    d[1] = make_uint4(o[4], o[5], o[6], o[7]);
  }
}

struct CJob { int src, ld, c0, ncols, K; unsigned dst; int sc; };
#define WIN_E(r) ((unsigned)(WOFF_IN / 2) + (unsigned)(r) * 1024u)
#define WUQ_E(r) ((unsigned)(WOFF_UQ / 2) + (unsigned)(r) * 256u)
__device__ const CJob cjobs[32] = {
    {0, P_TOTAL, 0, 1536, 1024, WIN_E(0), 0},       {0, P_TOTAL, 1536, 512, 1024, WIN_E(1536), 0},
    {0, P_TOTAL, 2464, 512, 1024, WIN_E(2048), 0},  {0, P_TOTAL, 3744, 512, 1024, WIN_E(2560), 0},
    {0, P_TOTAL, 2048, 256, 1024, WIN_E(3072), 0},  {0, P_TOTAL, 2304, 128, 1024, WIN_E(3328), 0},
    {0, P_TOTAL, 2976, 512, 1024, WIN_E(3456), 0},  {0, P_TOTAL, 3488, 128, 1024, WIN_E(3968), 0},
    {0, P_TOTAL, 3616, 128, 1024, WIN_E(4096), 0},  {0, P_TOTAL, 2432, 32, 1024, WIN_E(4224), 0},
    {0, P_TOTAL, 4256, 3072, 1024, WIN_E(4352), 0},
    {1, 768, 0, 64, 256, WUQ_E(0), 1},     {1, 768, 64, 32, 256, WUQ_E(512), 1},
    {1, 768, 96, 64, 256, WUQ_E(64), 1},   {1, 768, 160, 32, 256, WUQ_E(544), 1},
    {1, 768, 192, 64, 256, WUQ_E(128), 1}, {1, 768, 256, 32, 256, WUQ_E(576), 1},
    {1, 768, 288, 64, 256, WUQ_E(192), 1}, {1, 768, 352, 32, 256, WUQ_E(608), 1},
    {1, 768, 384, 64, 256, WUQ_E(256), 1}, {1, 768, 448, 32, 256, WUQ_E(640), 1},
    {1, 768, 480, 64, 256, WUQ_E(320), 1}, {1, 768, 544, 32, 256, WUQ_E(672), 1},
    {1, 768, 576, 64, 256, WUQ_E(384), 1}, {1, 768, 640, 32, 256, WUQ_E(704), 1},
    {1, 768, 672, 64, 256, WUQ_E(448), 1}, {1, 768, 736, 32, 256, WUQ_E(736), 1},
    {2, 1024, 0, 1024, 128, (unsigned)(WOFF_UKV / 2), 2},
    {3, 1024, 0, 1024, 512, (unsigned)(WOFF_P / 2), 0},
    {4, 1024, 0, 1024, 512, (unsigned)(WOFF_P / 2) + 1024u * 512u, 0},
    {5, 1024, 0, 1024, 512, (unsigned)(WOFF_P / 2) + 2u * 1024u * 512u, 0},
    {6, 1024, 0, 1024, 1024, (unsigned)(WOFF_OUT / 2), 0}};

DI void phase_convert(const P& p, int l, unsigned char* smem) {
  bf16_t* W = (bf16_t*)(p.ws + OFF_W);
  for (int i = blockIdx.x * 256 + tidx(); i < 96 * 1024 / 2; i += gridDim.x * 256)
    ((unsigned*)(W + WOFF_IN / 2 + (size_t)4256 * 1024))[i] = 0u;
  int g = blockIdx.x;
  int base = 0;
#pragma unroll 1
  for (int j = 0; j < 32; ++j) {
    CJob jb = cjobs[j];
    int nt = (jb.K >> 6) * ((jb.ncols + 63) >> 6);
    const float* src;
    switch (jb.src) {
      case 0: src = p.w_in + (size_t)l * 1024 * P_TOTAL; break;
      case 1: src = p.w_uq + (size_t)l * 256 * 768; break;
      case 2: src = p.w_ukv + (size_t)l * 128 * 1024; break;
      case 3: src = p.wp_hy + (size_t)l * 512 * 1024; break;
      case 4: src = p.wp_mla + (size_t)l * 512 * 1024; break;
      case 5: src = p.wp_swa + (size_t)l * 512 * 1024; break;
      default: src = p.w_out + (size_t)l * 1024 * 1024; break;
    }
    const float* sc = jb.sc == 1 ? p.q_norm + (size_t)l * 256 : (jb.sc == 2 ? p.kv_norm + (size_t)l * 128 : nullptr);
    while (g < base + nt) {
      convert_tile(src, jb.ld, jb.c0, jb.ncols, jb.K, W + jb.dst, sc, g - base, smem);
      g += gridDim.x;
    }
    base += nt;
  }
}

DI void filter_item(const P& p, int l, int L, int p0, bool isctx, unsigned char* smem) {
  float* zf = (float*)smem;
  float* ha = zf + 16 * 33;
  float* hb = ha + 16 * 64;
  const int t = tidx();
  const float* w1 = p.fw1 + (size_t)l * 33 * 64;
  const float* b1 = p.fb1 + l * 64;
  const float* w2 = p.fw2 + (size_t)l * 64 * 64;
  const float* b2 = p.fb2 + l * 64;
  const float* w3 = p.fw3 + (size_t)l * 64 * 64;
  const float* b3 = p.fb3 + l * 64;
  const float* fr = p.ffreq + l * 64;
  const float* wo = p.fwout + (size_t)l * 64 * 1024;
  __syncthreads();
  for (int i = t; i < 16 * 33; i += 256) {
    int pos = i / 33, f = i % 33;
    int pp = p0 + pos;
    float tt = (float)pp / (float)(L - 1);
    float wv = 6.283185307179586f * (float)pp / (float)L;
    float val;
    if (f == 0) val = tt;
    else {
      int j = (f - 1) & 15;
      float fq = 1e-4f + (float)j * ((15.f - 1e-4f) / 15.f);
      float ang = wv * fq;
      val = (f <= 16) ? __cosf(ang) : -__sinf(ang);
    }
    zf[pos * 33 + f] = val;
  }
  __syncthreads();
  const int unit = t & 63;
  const float fru = fr[unit];
  {
    float s4[4];
#pragma unroll
    for (int i = 0; i < 4; ++i) s4[i] = b1[unit];
#pragma unroll 1
    for (int f0 = 0; f0 < 33; f0 += 11) {
      float wr[11];
#pragma unroll
      for (int f = 0; f < 11; ++f) wr[f] = w1[(f0 + f) * 64 + unit];
#pragma unroll
      for (int f = 0; f < 11; ++f) {
#pragma unroll
        for (int i = 0; i < 4; ++i) s4[i] += zf[((t >> 6) + 4 * i) * 33 + f0 + f] * wr[f];
      }
    }
#pragma unroll
    for (int i = 0; i < 4; ++i) ha[((t >> 6) + 4 * i) * 64 + unit] = __sinf(fru * s4[i]);
  }
  __syncthreads();
  {
    float s4[4];
#pragma unroll
    for (int i = 0; i < 4; ++i) s4[i] = b2[unit];
#pragma unroll 1
    for (int f0 = 0; f0 < 64; f0 += 16) {
      float wr[16];
#pragma unroll
      for (int f = 0; f < 16; ++f) wr[f] = w2[(f0 + f) * 64 + unit];
#pragma unroll
      for (int f = 0; f < 16; ++f) {
#pragma unroll
        for (int i = 0; i < 4; ++i) s4[i] += ha[((t >> 6) + 4 * i) * 64 + f0 + f] * wr[f];
      }
    }
#pragma unroll
    for (int i = 0; i < 4; ++i) hb[((t >> 6) + 4 * i) * 64 + unit] = __sinf(fru * s4[i]);
  }
  __syncthreads();
  {
    float s4[4];
#pragma unroll
    for (int i = 0; i < 4; ++i) s4[i] = b3[unit];
#pragma unroll 1
    for (int f0 = 0; f0 < 64; f0 += 16) {
      float wr[16];
#pragma unroll
      for (int f = 0; f < 16; ++f) wr[f] = w3[(f0 + f) * 64 + unit];
#pragma unroll
      for (int f = 0; f < 16; ++f) {
#pragma unroll
        for (int i = 0; i < 4; ++i) s4[i] += hb[((t >> 6) + 4 * i) * 64 + f0 + f] * wr[f];
      }
    }
#pragma unroll
    for (int i = 0; i < 4; ++i) ha[unit * 16 + ((t >> 6) + 4 * i)] = __sinf(fru * s4[i]);
  }
  __syncthreads();
  const float min_decay = -3.0701134573253945f, max_decay = -15.350567286626973f;
  bf16_t* Fg = (bf16_t*)(p.ws + OFF_FG);
  float* Fc = (float*)(p.ws + OFF_FC);
  float* T = (float*)(smem + 12288);
#pragma unroll 1
  for (int dir = 0; dir < 2; ++dir) {
#pragma unroll 1
    for (int qq = 0; qq < 2; ++qq) {
      int ch = t + 256 * qq;
      int col = dir * 512 + ch;
      float acc[16];
#pragma unroll
      for (int i = 0; i < 16; ++i) acc[i] = 0.f;
#pragma unroll 1
      for (int k0 = 0; k0 < 64; k0 += 16) {
        float wr[16];
#pragma unroll
        for (int k = 0; k < 16; ++k) wr[k] = wo[(k0 + k) * 1024 + col];
#pragma unroll
        for (int k = 0; k < 16; ++k) {
#pragma unroll
          for (int i = 0; i < 16; ++i) acc[i] += ha[(k0 + k) * 16 + i] * wr[k];
        }
      }
      float delta = fabsf(min_decay + (max_decay - min_decay) * ((float)ch / 511.f));
      float skip = p.hy_skip[l * 512 + ch];
#pragma unroll
      for (int i = 0; i < 16; ++i) {
        int pp = p0 + i;
        float tt = (float)pp / (float)(L - 1);
        float v = acc[i] * __expf(-tt * delta);
        if (dir == 0 && pp == 0) v += skip;
        T[ch * 17 + i] = v;
      }
    }
    __syncthreads();
    for (int idx = t; idx < 8192; idx += 256) {
      int ch = idx >> 4, i = idx & 15;
      int pp = p0 + i;
      float v = T[ch * 17 + i];
      if (!isctx) {
        if (dir == 0) Fg[(size_t)ch * 16384 + (8192 - pp)] = f2bf(v);
        else if (pp == 0) Fg[(size_t)ch * 16384] = 0;
        else Fg[(size_t)ch * 16384 + 8192 + pp] = f2bf(v);
      } else {
        if (dir == 0) Fc[(size_t)(255 + pp) * 512 + ch] = v;
        else if (pp > 0) Fc[(size_t)(255 - pp) * 512 + ch] = v;
      }
    }
    __syncthreads();
  }
}

DI void ln_modulate_store(const float4 (&v)[4], const float* __restrict__ modv, bf16_t* __restrict__ urow, int lane) {
  float s = 0.f;
#pragma unroll
  for (int i = 0; i < 4; ++i) s += v[i].x + v[i].y + v[i].z + v[i].w;
  float mean = wave_sum(s) * (1.f / 1024.f);
  float q = 0.f;
#pragma unroll
  for (int i = 0; i < 4; ++i) {
    float a = v[i].x - mean, b = v[i].y - mean, c = v[i].z - mean, d = v[i].w - mean;
    q += a * a + b * b + c * c + d * d;
  }
  float rstd = rsqrtf(wave_sum(q) * (1.f / 1024.f) + 1e-6f);
#pragma unroll
  for (int i = 0; i < 4; ++i) {
    int col = 4 * lane + 256 * i;
    float4 sh = *(const float4*)(modv + col);
    float4 sc = *(const float4*)(modv + 1024 + col);
    float y0 = (v[i].x - mean) * rstd * (1.f + sc.x) + sh.x;
    float y1 = (v[i].y - mean) * rstd * (1.f + sc.y) + sh.y;
    float y2 = (v[i].z - mean) * rstd * (1.f + sc.z) + sh.z;
    float y3 = (v[i].w - mean) * rstd * (1.f + sc.w) + sh.w;
    uint2 o;
    o.x = pk2(y0, y1);
    o.y = pk2(y2, y3);
    *(uint2*)(urow + col) = o;
  }
}

DI void phase_ln0(const P& p) {
  const int lane = tidx() & 63, w = tidx() >> 6;
  bf16_t* U = (bf16_t*)(p.ws + OFF_U);
  const float* mod = (const float*)(p.ws + OFF_MOD);
  for (int item = blockIdx.x; item < R_ALL / 4; item += gridDim.x) {
    int row = item * 4 + w;
    const float* src = row < R_LAT ? p.x + (size_t)row * 1024 : p.ctx + (size_t)(row - R_LAT) * 1024;
    int v = row < R_LAT ? (row >> 13) : 2;
    float4 x[4];
#pragma unroll
    for (int i = 0; i < 4; ++i) x[i] = *(const float4*)(src + 4 * lane + 256 * i);
    ln_modulate_store(x, mod + (size_t)v * 3072, U + (size_t)row * 1024, lane);
  }
}

DI void phase_lnG(const P& p, int l) {
  const int lane = tidx() & 63, w = tidx() >> 6;
  bf16_t* U = (bf16_t*)(p.ws + OFF_U);
  const float* mod = (const float*)(p.ws + OFF_MOD) + (size_t)(l + 1) * 3 * 3072;
  const float* lg = p.ln_g + l * 1024;
  const float* lb = p.ln_b + l * 1024;
  float* zc = (float*)(p.ws + OFF_ZC);
  const int nrows = (l == 0) ? R_ALL : R_LAT;
  for (int item = blockIdx.x; item < nrows / 4; item += gridDim.x) {
    int row = item * 4 + w;
    float* src = row < R_LAT ? p.out + (size_t)row * 1024 : zc + (size_t)(row - R_LAT) * 1024;
    float4 x[4];
    float s = 0.f;
#pragma unroll
    for (int i = 0; i < 4; ++i) {
      x[i] = *(const float4*)(src + 4 * lane + 256 * i);
      s += x[i].x + x[i].y + x[i].z + x[i].w;
    }
    float mean = wave_sum(s) * (1.f / 1024.f);
    float q = 0.f;
#pragma unroll
    for (int i = 0; i < 4; ++i) {
      float a = x[i].x - mean, b = x[i].y - mean, c = x[i].z - mean, d = x[i].w - mean;
      q += a * a + b * b + c * c + d * d;
    }
    float rstd = rsqrtf(wave_sum(q) * (1.f / 1024.f) + 1e-6f);
#pragma unroll
    for (int i = 0; i < 4; ++i) {
      int col = 4 * lane + 256 * i;
      float4 g = *(const float4*)(lg + col);
      float4 b = *(const float4*)(lb + col);
      x[i].x = (x[i].x - mean) * rstd * g.x + b.x;
      x[i].y = (x[i].y - mean) * rstd * g.y + b.y;
      x[i].z = (x[i].z - mean) * rstd * g.z + b.z;
      x[i].w = (x[i].w - mean) * rstd * g.w + b.w;
      if (row < R_LAT) *(float4*)(src + col) = x[i];
    }
    if (l == 0) {
      int v = row < R_LAT ? (row >> 13) : 2;
      ln_modulate_store(x, mod + (size_t)v * 3072, U + (size_t)row * 1024, lane);
    }
  }
}

DI float2 rope16f(float x1, float x2, float pos, int i, float div) {
  float inv = __builtin_amdgcn_exp2f(-(float)i * (13.287712379549449f / div));
  float ang = pos * inv;
  float c = __cosf(ang), s = __sinf(ang);
  return make_float2(x1 * c - x2 * s, x1 * s + x2 * c);
}
#define rope16(X1, X2, POS, I, DIV) do { float2 _rr = rope16f((X1), (X2), (POS), (I), (DIV)); (X1) = _rr.x; (X2) = _rr.y; } while (0)

DI void phase_gemm1(const P& p, int l, unsigned char* smem) {
  const bf16_t* U = (const bf16_t*)(p.ws + OFF_U);
  const bf16_t* Win = (const bf16_t*)(p.ws + OFF_W + WOFF_IN);
  bf16_t* HY = (bf16_t*)(p.ws + OFF_HY);
  bf16_t* GT = (bf16_t*)(p.ws + OFF_GATE);
  bf16_t* CQ = (bf16_t*)(p.ws + OFF_CQ);
  bf16_t* CKV = (bf16_t*)(p.ws + OFF_CKV);
  bf16_t* KR = (bf16_t*)(p.ws + OFF_KR);
  bf16_t* SQ = (bf16_t*)(p.ws + OFF_SQ);
  bf16_t* SK = (bf16_t*)(p.ws + OFF_SK);
  bf16_t* SVT = (bf16_t*)(p.ws + OFF_SVT);
  const int lane = tidx() & 63, wave = tidx() >> 6;
  const int r = lane & 31, h = lane >> 5, wn = wave & 1, wm = wave >> 1;
  const int NMT = R_ALL / 128, NNT = N1 / 128;
  for (int k = 0; k * (int)gridDim.x < NMT * NNT; ++k) {
    int item = xcd_item(k);
    if (item >= NMT * NNT) continue;
    int ntile, mtile;
    if (item < 4 * NMT * 8) { int pnl = item / (NMT * 8), rem = item % (NMT * 8); mtile = rem >> 3; ntile = pnl * 8 + (rem & 7); }
    else { int rem = item - 4 * NMT * 8; mtile = rem >> 1; ntile = 32 + (rem & 1); }
    f32x16 acc[2][2];
    zero_acc(acc);
    gemm_core<true>(Win + (size_t)ntile * 128 * 1024, 1024, U + (size_t)mtile * 128 * 1024, 1024, 1024, acc, smem);
#pragma unroll
    for (int mt = 0; mt < 2; ++mt) {
      int m = mtile * 128 + wm * 64 + mt * 32 + r;
      RowInfo ri = row_info(m);
#pragma unroll
      for (int nt = 0; nt < 2; ++nt) {
        int nl = wn * 64 + nt * 32 + 4 * h;
        f32x16& a = acc[nt][mt];
        if (ntile < 12) {
#pragma unroll
          for (int g = 0; g < 4; ++g) {
            uint2 o = {pk2(a[4 * g], a[4 * g + 1]), pk2(a[4 * g + 2], a[4 * g + 3])};
            *(uint2*)(HY + (size_t)m * 1536 + ntile * 128 + nl + 8 * g) = o;
          }
        } else if (ntile < 24) {
#pragma unroll
          for (int g = 0; g < 4; ++g) {
            uint2 o = {pk2(silu_f(a[4 * g]), silu_f(a[4 * g + 1])), pk2(silu_f(a[4 * g + 2]), silu_f(a[4 * g + 3]))};
            *(uint2*)(GT + (size_t)m * 1536 + (ntile - 12) * 128 + nl + 8 * g) = o;
          }
        } else if (ntile < 26) {
#pragma unroll
          for (int g = 0; g < 4; ++g) {
            uint2 o = {pk2(a[4 * g], a[4 * g + 1]), pk2(a[4 * g + 2], a[4 * g + 3])};
            *(uint2*)(CQ + (size_t)m * 256 + (ntile - 24) * 128 + nl + 8 * g) = o;
          }
        } else if (ntile == 26) {
#pragma unroll
          for (int g = 0; g < 4; ++g) {
            uint2 o = {pk2(a[4 * g], a[4 * g + 1]), pk2(a[4 * g + 2], a[4 * g + 3])};
            *(uint2*)(CKV + (size_t)m * 128 + nl + 8 * g) = o;
          }
        } else if (ntile < 32) {
          float pos = ri.isctx ? 0.f : (nt == 0 ? (float)ri.prow : (float)ri.pcol);
#pragma unroll
          for (int g = 0; g < 2; ++g)
#pragma unroll
            for (int e = 0; e < 4; ++e) rope16(a[4 * g + e], a[4 * (g + 2) + e], pos, 8 * g + 4 * h + e, 16.f);
          const float sc = (ntile < 31) ? 0.125f * 1.4426950408889634f : 1.f;
          bf16_t* dst = (ntile < 31) ? SQ + (size_t)m * 512 + (ntile - 27) * 128 + nl : SK + (size_t)m * 128 + nl;
#pragma unroll
          for (int g = 0; g < 4; ++g) {
            uint2 o = {pk2(a[4 * g] * sc, a[4 * g + 1] * sc), pk2(a[4 * g + 2] * sc, a[4 * g + 3] * sc)};
            *(uint2*)(dst + 8 * g) = o;
          }
        } else if (ntile == 32) {
#pragma unroll
          for (int g = 0; g < 4; ++g)
#pragma unroll
            for (int e = 0; e < 4; ++e) {
              int d = nt * 32 + 8 * g + 4 * h + e;
              SVT[((size_t)(ri.b * 2 + wn) * 64 + d) * NKEY + ri.kidx] = f2bf(a[4 * g + e]);
            }
        } else {
          if (wn == 0 && nt == 0) {
#pragma unroll
            for (int g = 0; g < 4; g += 2) {
              float pos = ri.isctx ? 0.f : (g == 0 ? (float)ri.prow : (float)ri.pcol);
#pragma unroll
              for (int e = 0; e < 4; ++e) rope16(a[4 * g + e], a[4 * (g + 1) + e], pos, 4 * h + e, 8.f);
            }
#pragma unroll
            for (int g = 0; g < 4; ++g) {
              uint2 o = {pk2(a[4 * g], a[4 * g + 1]), pk2(a[4 * g + 2], a[4 * g + 3])};
              *(uint2*)(KR + (size_t)m * 32 + 4 * h + 8 * g) = o;
            }
          }
        }
      }
    }
  }
  if (l == 0) {
    bf16_t* SGC = (bf16_t*)(p.ws + OFF_SGC);
    const int nb = gridDim.x, b = blockIdx.x;
    const int total = NMT * NNT, full = total / nb, remn = total - full * nb;
    const int myidx = (b & 7) * (nb >> 3) + (b >> 3);
    int first, step;
    if (remn > 0 && nb - remn >= 96) { first = (myidx >= remn) ? myidx - remn : 1 << 30; step = 1 << 30; }
    else { first = b; step = nb; }
    for (int e = first; e < 96; e += step) {
      int mtile = 128 + e / 24, nt24 = e % 24;
      f32x16 acc[2][2];
      zero_acc(acc);
      gemm_core<true>(Win + (size_t)(N1 + nt24 * 128) * 1024, 1024, U + (size_t)mtile * 128 * 1024, 1024, 1024, acc, smem);
#pragma unroll
      for (int mt = 0; mt < 2; ++mt) {
        int m = mtile * 128 + wm * 64 + mt * 32 + r - R_LAT;
#pragma unroll
        for (int nt = 0; nt < 2; ++nt) {
          int nl = wn * 64 + nt * 32 + 4 * h;
          f32x16& a = acc[nt][mt];
#pragma unroll
          for (int g = 0; g < 4; ++g) {
            uint2 o = {pk2(sigm_f(a[4 * g]), sigm_f(a[4 * g + 1])), pk2(sigm_f(a[4 * g + 2]), sigm_f(a[4 * g + 3]))};
            *(uint2*)(SGC + (size_t)m * 3072 + nt24 * 128 + nl + 8 * g) = o;
          }
        }
      }
    }
  }
}

DI void phase_hyprep(const P& p, int l, unsigned char* smem) {
  const bf16_t* __restrict__ HY = (const bf16_t*)(p.ws + OFF_HY);
  bf16_t* GT = (bf16_t*)(p.ws + OFF_GATE);
  bf16_t* UT = (bf16_t*)(p.ws + OFF_UT);
  float* UC = (float*)(p.ws + OFF_UC);
  bf16_t* tile = (bf16_t*)smem;
  const float* cw = p.hy_conv_w + (size_t)l * 3 * 1536;
  const float* cb = p.hy_conv_b + (size_t)l * 1536;
  const int t = tidx();
  const int c = 2 * t;
  const int nitems = (l == 0) ? R_ALL / 32 : R_LAT / 32;
  float w0[3][2], w1[3][2], w2[3][2], bb[3][2];
#pragma unroll
  for (int s3 = 0; s3 < 3; ++s3)
#pragma unroll
    for (int e = 0; e < 2; ++e) {
      w0[s3][e] = cw[0 * 1536 + s3 * 512 + c + e];
      w1[s3][e] = cw[1 * 1536 + s3 * 512 + c + e];
      w2[s3][e] = cw[2 * 1536 + s3 * 512 + c + e];
      bb[s3][e] = cb[s3 * 512 + c + e];
    }
  for (int item = blockIdx.x; item < nitems; item += gridDim.x) {
    int r0 = item * 32;
    bool isctx = r0 >= R_LAT;
    int seqlen = isctx ? LC : S_LAT;
    int t0 = isctx ? ((r0 - R_LAT) & (LC - 1)) : (r0 & (S_LAT - 1));
    int b = isctx ? ((r0 - R_LAT) >> 8) : (r0 >> 13);
    unsigned pv[3], cv[3];
#pragma unroll
    for (int s3 = 0; s3 < 3; ++s3) {
      pv[s3] = (t0 > 0) ? *(const unsigned*)(HY + (size_t)(r0 - 1) * 1536 + s3 * 512 + c) : 0u;
      cv[s3] = *(const unsigned*)(HY + (size_t)r0 * 1536 + s3 * 512 + c);
    }
    __syncthreads();
    for (int i0 = 0; i0 < 32; i0 += 16) {
      unsigned nv[16][3], gg[16];
#pragma unroll
      for (int ii = 0; ii < 16; ++ii) {
        int i = i0 + ii;
        bool hasn = (t0 + i + 1) < seqlen;
#pragma unroll
        for (int s3 = 0; s3 < 3; ++s3) nv[ii][s3] = hasn ? *(const unsigned*)(HY + (size_t)(r0 + i + 1) * 1536 + s3 * 512 + c) : 0u;
        gg[ii] = *(const unsigned*)(GT + (size_t)(r0 + i) * 1536 + c);
      }
#pragma unroll
      for (int ii = 0; ii < 16; ++ii) {
        int i = i0 + ii;
        int row = r0 + i;
        float z[3][2];
#pragma unroll
        for (int s3 = 0; s3 < 3; ++s3) {
          z[s3][0] = bb[s3][0] + w0[s3][0] * bflo(pv[s3]) + w1[s3][0] * bflo(cv[s3]) + w2[s3][0] * bflo(nv[ii][s3]);
          z[s3][1] = bb[s3][1] + w0[s3][1] * bfhi(pv[s3]) + w1[s3][1] * bfhi(cv[s3]) + w2[s3][1] * bfhi(nv[ii][s3]);
        }
        float uh0 = z[2][0] * z[1][0], uh1 = z[2][1] * z[1][1];
        *(unsigned*)(GT + (size_t)row * 1536 + c) = pk2(bflo(gg[ii]) * z[0][0], bfhi(gg[ii]) * z[0][1]);
        if (isctx) { *(float2*)(UC + (size_t)(row - R_LAT) * 512 + c) = make_float2(uh0, uh1); }
        else { tile[c * 34 + i] = f2bf(uh0); tile[(c + 1) * 34 + i] = f2bf(uh1); }
#pragma unroll
        for (int s3 = 0; s3 < 3; ++s3) { pv[s3] = cv[s3]; cv[s3] = nv[ii][s3]; }
      }
    }
    __syncthreads();
    if (!isctx) {
      for (int idx = t; idx < 512 * 16; idx += 256) {
        int cl = idx >> 4, pr = idx & 15;
        unsigned v = *(const unsigned*)(tile + cl * 34 + 2 * pr);
        *(unsigned*)(UT + (size_t)cl * 16384 + b * 8192 + t0 + 2 * pr) = v;
      }
    }
  }
}

DI void row_rms(const bf16_t* __restrict__ src, int ld, int ncol, float* rs  ) {
  const int t = tidx();
  int row = t >> 1, hf = t & 1;
  int per = ncol >> 1;
  const bf16_t* q = src + (size_t)row * ld + hf * per;
  float s = 0.f;
  for (int i = 0; i < per; i += 8) {
    uint4 v = *(const uint4*)(q + i);
    float a;
    a = bflo(v.x); s += a * a; a = bfhi(v.x); s += a * a;
    a = bflo(v.y); s += a * a; a = bfhi(v.y); s += a * a;
    a = bflo(v.z); s += a * a; a = bfhi(v.z); s += a * a;
    a = bflo(v.w); s += a * a; a = bfhi(v.w); s += a * a;
  }
  s += __shfl_xor(s, 1);
  if (hf == 0) rs[row] = rsqrtf(s / (float)ncol + 1e-6f);
}

DI void phase_upproj(const P& p, int l, unsigned char* smem, float* rs) {
  const bf16_t* CQ = (const bf16_t*)(p.ws + OFF_CQ);
  const bf16_t* CKV = (const bf16_t*)(p.ws + OFF_CKV);
  const bf16_t* Wuq = (const bf16_t*)(p.ws + OFF_W + WOFF_UQ);
  const bf16_t* Wukv = (const bf16_t*)(p.ws + OFF_W + WOFF_UKV);
  bf16_t* QN = (bf16_t*)(p.ws + OFF_QN);
  bf16_t* QR = (bf16_t*)(p.ws + OFF_QR);
  bf16_t* KN = (bf16_t*)(p.ws + OFF_KN);
  bf16_t* VTM = (bf16_t*)(p.ws + OFF_VTM);
  const int lane = tidx() & 63, wave = tidx() >> 6;
  const int r = lane & 31, h = lane >> 5, wn = wave & 1, wm = wave >> 1;
  const int NMT = R_ALL / 128;
  const int n_kv = NMT * 8;
  const int nmq = (l == 0) ? NMT : R_LAT / 128;
  const int n_q = nmq * 6;
  const float qscale = 0.10206207261596577f * 1.4426950408889634f;
  for (int item = blockIdx.x; item < n_kv + n_q; item += gridDim.x) {
    bool iskv = item < n_kv;
    int mtile, ntile;
    if (iskv) { mtile = item % NMT; ntile = item / NMT; }
    else { int it = item - n_kv; mtile = it % nmq; ntile = it / nmq; }
    f32x16 acc[2][2];
    zero_acc(acc);
    __syncthreads();
    if (iskv) row_rms(CKV + (size_t)mtile * 128 * 128, 128, 128, rs);
    else row_rms(CQ + (size_t)mtile * 128 * 256, 256, 256, rs);
    if (iskv) gemm_core(Wukv + (size_t)ntile * 128 * 128, 128, CKV + (size_t)mtile * 128 * 128, 128, 128, acc, smem);
    else gemm_core(Wuq + (size_t)ntile * 128 * 256, 256, CQ + (size_t)mtile * 128 * 256, 256, 256, acc, smem);
#pragma unroll
    for (int mt = 0; mt < 2; ++mt) {
      int ml = wm * 64 + mt * 32 + r;
      int m = mtile * 128 + ml;
      RowInfo ri = row_info(m);
      float rsv = rs[ml];
#pragma unroll
      for (int nt = 0; nt < 2; ++nt) {
        f32x16& a = acc[nt][mt];
        int nl = wn * 64 + nt * 32 + 4 * h;
        if (iskv) {
          if (wn == 0) {
#pragma unroll
            for (int g = 0; g < 4; ++g) {
              uint2 o = {pk2(a[4 * g] * rsv, a[4 * g + 1] * rsv), pk2(a[4 * g + 2] * rsv, a[4 * g + 3] * rsv)};
              *(uint2*)(KN + (size_t)m * 512 + ntile * 64 + nt * 32 + 4 * h + 8 * g) = o;
            }
          } else {
#pragma unroll
            for (int g = 0; g < 4; ++g)
#pragma unroll
              for (int e = 0; e < 4; ++e) {
                int d = nt * 32 + 8 * g + 4 * h + e;
                VTM[((size_t)(ri.b * 8 + ntile) * 64 + d) * NKEY + ri.kidx] = f2bf(a[4 * g + e] * rsv);
              }
          }
        } else {
          float sc = rsv * qscale;
          if (ntile < 4) {
#pragma unroll
            for (int g = 0; g < 4; ++g) {
              uint2 o = {pk2(a[4 * g] * sc, a[4 * g + 1] * sc), pk2(a[4 * g + 2] * sc, a[4 * g + 3] * sc)};
              *(uint2*)(QN + (size_t)m * 512 + ntile * 128 + nl + 8 * g) = o;
            }
          } else {
#pragma unroll
            for (int g = 0; g < 4; g += 2) {
              float pos = ri.isctx ? 0.f : (g == 0 ? (float)ri.prow : (float)ri.pcol);
#pragma unroll
              for (int e = 0; e < 4; ++e) rope16(a[4 * g + e], a[4 * (g + 1) + e], pos, 4 * h + e, 8.f);
            }
#pragma unroll
            for (int g = 0; g < 4; ++g) {
              uint2 o = {pk2(a[4 * g] * sc, a[4 * g + 1] * sc), pk2(a[4 * g + 2] * sc, a[4 * g + 3] * sc)};
              *(uint2*)(QR + (size_t)m * 256 + (ntile - 4) * 128 + nl + 8 * g) = o;
            }
          }
        }
      }
    }
  }
}

constexpr int KROW = 208;
constexpr int VROW = 136;
constexpr int ATT_BUF = 64 * KROW + 64 * VROW;

template <int DQK>
DI void attn_load(const bf16_t* __restrict__ ka, int lda, const bf16_t* __restrict__ kb, const bf16_t* __restrict__ vt,
                  int krow0, int kcol0, uint4& g0, uint4& g1, uint4& g2, uint4& g3, uint4& g4) {
  const int t = tidx();
  {
    int key = t >> 3, c = t & 7;
    g0 = *(const uint4*)(ka + (size_t)(krow0 + key) * lda + c * 8);
    g1 = *(const uint4*)(ka + (size_t)(krow0 + 32 + key) * lda + c * 8);
    g2 = *(const uint4*)(vt + (size_t)key * NKEY + kcol0 + c * 8);
    g3 = *(const uint4*)(vt + (size_t)(32 + key) * NKEY + kcol0 + c * 8);
  }
  if constexpr (DQK == 96) {
    int key = t >> 2, c = t & 3;
    g4 = *(const uint4*)(kb + (size_t)(krow0 + key) * 32 + c * 8);
  }
}
template <int DQK>
DI void attn_store(unsigned char* buf, const uint4& g0, const uint4& g1, const uint4& g2, const uint4& g3, const uint4& g4) {
  const int t = tidx();
  {
    int key = t >> 3, c = t & 7;
    *(uint4*)(buf + key * KROW + c * 16) = g0;
    *(uint4*)(buf + (32 + key) * KROW + c * 16) = g1;
    unsigned char* q = buf + 64 * KROW + key * VROW + c * 16;
    *(uint2*)(q) = make_uint2(g2.x, g2.y);
    *(uint2*)(q + 8) = make_uint2(g2.z, g2.w);
    q += 32 * VROW;
    *(uint2*)(q) = make_uint2(g3.x, g3.y);
    *(uint2*)(q + 8) = make_uint2(g3.z, g3.w);
  }
  if constexpr (DQK == 96) {
    int key = t >> 2, c = t & 3;
    *(uint4*)(buf + key * KROW + 128 + c * 16) = g4;
  }
}

template <bool MASK>
DI void attn_half(f32x16& s, f32x16& sother, int T, const unsigned char* vb, bool domask, int kpc, int qpos, f32x16& negm,
                  float& lsum, f32x16 (&o)[2], int h, bool first) {
  if (MASK && domask) {
#pragma unroll
    for (int i = 0; i < 16; ++i) {
      int kk = kpc + 32 * T + (i & 3) + 8 * (i >> 2) + 4 * h;
      int d0 = qpos - kk;
      if (d0 > 128 || d0 < -128) s[i] = -1e30f;
    }
  }
  float mx = fmaxf(fmaxf(s[0], s[1]), s[2]);
#pragma unroll
  for (int i = 3; i < 15; i += 2) mx = fmaxf(fmaxf(mx, s[i]), s[i + 1]);
  mx = fmaxf(mx, s[15]);
  if (first || __builtin_amdgcn_ballot_w64(mx > 8.f) != 0ull) {
    mx = fmaxf(mx, __shfl_xor(mx, 32));
    float d = first ? mx : fmaxf(mx, 0.f);
    float alpha = first ? 1.f : __builtin_amdgcn_exp2f(-d);
    lsum *= alpha;
#pragma unroll
    for (int i = 0; i < 16; ++i) { o[0][i] *= alpha; o[1][i] *= alpha; s[i] -= d; negm[i] -= d; }
    if (T == 0) {
#pragma unroll
      for (int i = 0; i < 16; ++i) sother[i] -= d;
    }
  }
#pragma unroll
  for (int i = 0; i < 16; ++i) {
    s[i] = __builtin_amdgcn_exp2f(s[i]);
    lsum += s[i];
  }
#pragma unroll
  for (int st = 0; st < 2; ++st) {
    bf16x8 pb = MKFRAG(pk2(s[8 * st + 0], s[8 * st + 1]), pk2(s[8 * st + 2], s[8 * st + 3]),
                       pk2(s[8 * st + 4], s[8 * st + 5]), pk2(s[8 * st + 6], s[8 * st + 7]));
#pragma unroll
    for (int mt = 0; mt < 2; ++mt) {
      const unsigned char* vp = vb + (32 * mt) * VROW + (32 * T + 16 * st) * 2;
      uint2 lo = *(const uint2*)(vp);
      uint2 hi = *(const uint2*)(vp + 16);
      bf16x8 av = MKFRAG(lo.x, lo.y, hi.x, hi.y);
      o[mt] = MFMA(av, pb, o[mt]);
    }
  }
}

template <int DQK, bool MASK>
DI void attn_compute(const unsigned char* cur, const bf16x8 (&qf)[DQK / 16], bool domask, int kpc, int qpos, f32x16& negm,
                     float& lsum, f32x16 (&o)[2], int r, int h, bool first) {
  f32x16 s0 = negm, s1 = negm;
  __builtin_amdgcn_s_setprio(1);
#pragma unroll
  for (int ks = 0; ks < DQK / 16; ++ks) {
    bf16x8 a0 = *(const bf16x8*)(cur + r * KROW + (2 * ks + h) * 16);
    s0 = MFMA(a0, qf[ks], s0);
  }
#pragma unroll
  for (int ks = 0; ks < DQK / 16; ++ks) {
    bf16x8 a1 = *(const bf16x8*)(cur + (32 + r) * KROW + (2 * ks + h) * 16);
    s1 = MFMA(a1, qf[ks], s1);
  }
  __builtin_amdgcn_s_setprio(0);
  const unsigned char* vb = cur + 64 * KROW + r * VROW + 8 * h;
  attn_half<MASK>(s0, s1, 0, vb, domask, kpc, qpos, negm, lsum, o, h, first);
  attn_half<MASK>(s1, s0, 1, vb, domask, kpc, qpos, negm, lsum, o, h, false);
}

#define A_LOAD(S, IT)                                                                                     \
  {                                                                                                       \
    int itn_ = (IT);                                                                                      \
    int kp_ = wlo + (itn_ - 4) * 64;                                                                      \
    int krow0_ = (itn_ < 4) ? ctxrow0 + itn_ * 64 : latrow0 + kp_;                                        \
    int kcol0_ = (itn_ < 4) ? itn_ * 64 : LC + kp_;                                                       \
    attn_load<DQK>(ka, lda, kb, vt, krow0_, kcol0_, S##0, S##1, S##2, S##3, S##4);                        \
  }
template <int DQK, bool MASK>
DI void attn_block(const bf16_t* __restrict__ ka, int lda, const bf16_t* __restrict__ kb, const bf16_t* __restrict__ vt,
                   const bf16x8 (&qf)[DQK / 16], int ntiles, int ctxrow0, int latrow0, int wlo, int qpos,
                   float m_init, float l_init, f32x16 (&o)[2], float& l_out, unsigned char* smem) {
  const int lane = tidx() & 63;
  const int r = lane & 31, h = lane >> 5;
  uint4 ga0, ga1, ga2, ga3, ga4, gb0, gb1, gb2, gb3, gb4;
  const bool nofs = m_init < -1e29f;
  float lsum = l_init;
  f32x16 negm;
#pragma unroll
  for (int i = 0; i < 16; ++i) { o[0][i] = 0.f; o[1][i] = 0.f; negm[i] = nofs ? 0.f : -m_init; }
  A_LOAD(ga, 0);
  A_LOAD(gb, 1);
  __syncthreads();
  attn_store<DQK>(smem, ga0, ga1, ga2, ga3, ga4);
  if (ntiles > 2) A_LOAD(ga, 2);
  __syncthreads();
  for (int it = 0; it < ntiles; it += 2) {
    attn_compute<DQK, MASK>(smem, qf, it >= 4, wlo + (it - 4) * 64, qpos, negm, lsum, o, r, h, nofs && it == 0);
    attn_store<DQK>(smem + ATT_BUF, gb0, gb1, gb2, gb3, gb4);
    if (it + 3 < ntiles) A_LOAD(gb, it + 3);
    __syncthreads();
    attn_compute<DQK, MASK>(smem + ATT_BUF, qf, it + 1 >= 4, wlo + (it - 3) * 64, qpos, negm, lsum, o, r, h, false);
    if (it + 2 < ntiles) {
      attn_store<DQK>(smem, ga0, ga1, ga2, ga3, ga4);
      if (it + 4 < ntiles) A_LOAD(ga, it + 4);
    }
    __syncthreads();
  }
  l_out = lsum + __shfl_xor(lsum, 32);
}

DI void attn_finish(f32x16 (&o)[2], float l, bf16_t* grow  ) {
  const int lane = tidx() & 63;
  const int h = lane >> 5;
  float inv = 1.f / l;
  uint2 gv[2][4];
#pragma unroll
  for (int mt = 0; mt < 2; ++mt)
#pragma unroll
    for (int g = 0; g < 4; ++g) gv[mt][g] = *(const uint2*)(grow + 32 * mt + 8 * g + 4 * h);
#pragma unroll
  for (int mt = 0; mt < 2; ++mt)
#pragma unroll
    for (int g = 0; g < 4; ++g) {
      float y0 = o[mt][4 * g] * inv * bflo(gv[mt][g].x);
      float y1 = o[mt][4 * g + 1] * inv * bfhi(gv[mt][g].x);
      float y2 = o[mt][4 * g + 2] * inv * bflo(gv[mt][g].y);
      float y3 = o[mt][4 * g + 3] * inv * bfhi(gv[mt][g].y);
      uint2 ov = {pk2(y0, y1), pk2(y2, y3)};
      *(uint2*)(grow + 32 * mt + 8 * g + 4 * h) = ov;
    }
}

DI void mla_item(const P& p, int b, int hh, int qb, bool ctxq, unsigned char* smem, bool dry = false) {
  const bf16_t* QN = (const bf16_t*)(p.ws + OFF_QN);
  const bf16_t* QR = (const bf16_t*)(p.ws + OFF_QR);
  bf16_t* GT = (bf16_t*)(p.ws + OFF_GATE);
  const int lane = tidx() & 63, wave = tidx() >> 6;
  const int r = lane & 31, h = lane >> 5;
  const bf16_t* ka = (const bf16_t*)(p.ws + OFF_KN) + hh * 64;
  const bf16_t* kb = (const bf16_t*)(p.ws + OFF_KR);
  const bf16_t* vt = (const bf16_t*)(p.ws + OFF_VTM) + (size_t)(b * 8 + hh) * 64 * NKEY;
  int qrow = (ctxq ? R_LAT + b * LC : b * S_LAT) + qb * 128 + wave * 32 + r;
  bf16x8 qf[6];
#pragma unroll
  for (int ks = 0; ks < 4; ++ks) qf[ks] = *(const bf16x8*)(QN + (size_t)qrow * 512 + hh * 64 + ks * 16 + 8 * h);
#pragma unroll
  for (int ks = 0; ks < 2; ++ks) qf[4 + ks] = *(const bf16x8*)(QR + (size_t)qrow * 256 + hh * 32 + ks * 16 + 8 * h);
  const int ctxrow0 = R_LAT + b * LC, latrow0 = b * S_LAT;
  f32x16 o[2];
  float l;
  attn_block<96, false>(ka, 512, kb, vt, qf, ctxq ? 4 : NKEY / 64, ctxrow0, latrow0, 0, 0, -1e30f, 0.f, o, l, smem);
  if (!dry || p.phase_lo < 0) attn_finish(o, l, GT + (size_t)qrow * 1536 + 512 + hh * 64);
}

DI void swa_item(const P& p, int l_, int b, int hd, int qb, bool ctxq, unsigned char* smem, bool dry = false) {
  const bf16_t* SQ = (const bf16_t*)(p.ws + OFF_SQ);
  bf16_t* GT = (bf16_t*)(p.ws + OFF_GATE);
  const int lane = tidx() & 63, wave = tidx() >> 6;
  const int r = lane & 31, h = lane >> 5;
  const int g = hd >> 2;
  const bf16_t* ka = (const bf16_t*)(p.ws + OFF_SK) + g * 64;
  const bf16_t* vt = (const bf16_t*)(p.ws + OFF_SVT) + (size_t)(b * 2 + g) * 64 * NKEY;
  int qpos = qb * 128 + wave * 32 + r;
  int qrow = (ctxq ? R_LAT + b * LC : b * S_LAT) + qpos;
  bf16x8 qf[4];
#pragma unroll
  for (int ks = 0; ks < 4; ++ks) qf[ks] = *(const bf16x8*)(SQ + (size_t)qrow * 512 + hd * 64 + ks * 16 + 8 * h);
  const int ctxrow0 = R_LAT + b * LC, latrow0 = b * S_LAT;
  int wlo = (qb - 1) * 128; if (wlo < 0) wlo = 0;
  int whi = (qb + 2) * 128; if (whi > S_LAT) whi = S_LAT;
  int nt = ctxq ? 4 : 4 + (whi - wlo) / 64;
  float sk = p.sink[l_ * 8 + hd] * 1.4426950408889634f;
  f32x16 o[2];
  float l;
  attn_block<64, true>(ka, 128, nullptr, vt, qf, nt, ctxrow0, latrow0, wlo, qpos, sk, (h == 0) ? 1.f : 0.f, o, l, smem);
  if (!dry || p.phase_lo < 0) attn_finish(o, l, GT + (size_t)qrow * 1536 + 1024 + hd * 64);
}

DI void hyena_item(const P& p, int c, unsigned char* smem, bool dry = false) {
  const bf16_t* Fg = (const bf16_t*)(p.ws + OFF_FG) + (size_t)c * 16384;
  const bf16_t* UT = (const bf16_t*)(p.ws + OFF_UT) + (size_t)c * 16384;
  bf16_t* GT = (bf16_t*)(p.ws + OFF_GATE);
  const int t = tidx();
  const int lane = t & 63, wave = t >> 6;
  const int r = lane & 31, h = lane >> 5;
  const unsigned* F32 = (const unsigned*)smem;
  unsigned char* Ub = smem + 32768;
  __syncthreads();
#pragma unroll
  for (int i = 0; i < 8; ++i) {
    int idx = t + 256 * i;
    *(uint4*)(smem + idx * 16) = *(const uint4*)(Fg + idx * 8);
    int bb = idx >> 10, j = (idx >> 3) & 127, ch = idx & 7;
    uint4 v = *(const uint4*)(UT + idx * 8);
    *(uint4*)(Ub + bb * 16512 + j * 128 + ((ch ^ ((j >> 1) & 7)) << 4)) = v;
  }
  if (t < 16) *(uint4*)(Ub + (t >> 3) * 16512 + 128 * 128 + (t & 7) * 16) = make_uint4(0u, 0u, 0u, 0u);
  __syncthreads();
  const int ibase = 32 * wave;
  f32x16 acc[2][2];
  zero_acc(acc);
#define HY_FRAG(DST, Q)                                                                              \
  {                                                                                                  \
    int z0_ = 8192 - 16 * (Q) - r + 8 * h;                                                           \
    int dw_ = z0_ >> 1;                                                                              \
    unsigned x0_ = F32[dw_], x1_ = F32[dw_ + 1], x2_ = F32[dw_ + 2], x3_ = F32[dw_ + 3], x4_ = F32[dw_ + 4]; \
    DST = MKFRAG(__builtin_amdgcn_alignbit(x1_, x0_, sh), __builtin_amdgcn_alignbit(x2_, x1_, sh),    \
                 __builtin_amdgcn_alignbit(x3_, x2_, sh), __builtin_amdgcn_alignbit(x4_, x3_, sh));   \
  }
  const unsigned sh = (unsigned)((r & 1) * 16);
  bf16x8 f0, f1, f2, f3, f4, f5;
  {
    const int d0 = ibase - 127;
    HY_FRAG(f4, 4 * d0 - 3);
    HY_FRAG(f5, 4 * d0 - 2);
  }
#pragma unroll 1
  for (int d = ibase - 127; d <= ibase + 31; ++d) {
    f0 = f4; f1 = f5;
    HY_FRAG(f2, 4 * d - 1);
    HY_FRAG(f3, 4 * d);
    HY_FRAG(f4, 4 * d + 1);
    HY_FRAG(f5, 4 * d + 2);
    int j = ibase - d + r;
    int jc = ((unsigned)j < 128u) ? j : 128;
    const unsigned char* ub = Ub + jc * 128;
    const int sw = (jc >> 1) & 7;
#pragma unroll
    for (int bt = 0; bt < 2; ++bt) {
      const unsigned char* ubb = ub + bt * 16512;
      bf16x8 b0 = *(const bf16x8*)(ubb + (((0 + h) ^ sw) << 4));
      bf16x8 b1 = *(const bf16x8*)(ubb + (((2 + h) ^ sw) << 4));
      bf16x8 b2 = *(const bf16x8*)(ubb + (((4 + h) ^ sw) << 4));
      bf16x8 b3 = *(const bf16x8*)(ubb + (((6 + h) ^ sw) << 4));
      acc[0][bt] = MFMA(f3, b0, acc[0][bt]); acc[1][bt] = MFMA(f5, b0, acc[1][bt]);
      acc[0][bt] = MFMA(f2, b1, acc[0][bt]); acc[1][bt] = MFMA(f4, b1, acc[1][bt]);
      acc[0][bt] = MFMA(f1, b2, acc[0][bt]); acc[1][bt] = MFMA(f3, b2, acc[1][bt]);
      acc[0][bt] = MFMA(f0, b3, acc[0][bt]); acc[1][bt] = MFMA(f2, b3, acc[1][bt]);
    }
  }
  if (!dry || p.phase_lo < 0)
#pragma unroll
  for (int mi = 0; mi < 2; ++mi)
#pragma unroll
    for (int bt = 0; bt < 2; ++bt) {
      int i = ibase + r;
      bf16_t gvals[16];
#pragma unroll
      for (int reg = 0; reg < 16; ++reg) {
        int a2 = 32 * mi + (reg & 3) + 8 * (reg >> 2) + 4 * h;
        size_t grow = (size_t)bt * 8192 + 64 * i + a2;
        gvals[reg] = GT[grow * 1536 + c];
      }
#pragma unroll
      for (int reg = 0; reg < 16; ++reg) {
        int a2 = 32 * mi + (reg & 3) + 8 * (reg >> 2) + 4 * h;
        size_t grow = (size_t)bt * 8192 + 64 * i + a2;
        GT[grow * 1536 + c] = f2bf(bf2f(gvals[reg]) * acc[mi][bt][reg]);
      }
    }
}

DI void hyena_ctx_item(const P& p, int item) {
  const float* __restrict__ Fc = (const float*)(p.ws + OFF_FC);
  const float* __restrict__ UC = (const float*)(p.ws + OFF_UC);
  bf16_t* GT = (bf16_t*)(p.ws + OFF_GATE);
  const int t = tidx();
  int r0 = item * 8;
  int b = r0 >> 8, t0 = r0 & 255;
  for (int hc = 0; hc < 2; ++hc) {
    int c = hc * 256 + t;
    float acc[8], win[8];
#pragma unroll
    for (int i = 0; i < 8; ++i) { acc[i] = 0.f; win[i] = Fc[(size_t)(255 + t0 + i) * 512 + c]; }
#pragma unroll 8
    for (int s = 0; s < 256; ++s) {
      float u = UC[(size_t)(b * 256 + s) * 512 + c];
#pragma unroll
      for (int i = 0; i < 8; ++i) acc[i] += win[i] * u;
#pragma unroll
      for (int i = 7; i > 0; --i) win[i] = win[i - 1];
      int nidx = 255 + t0 - s - 1;
      win[0] = (nidx >= 0) ? Fc[(size_t)nidx * 512 + c] : 0.f;
    }
#pragma unroll
    for (int i = 0; i < 8; ++i) {
      bf16_t* q = GT + (size_t)(R_LAT + r0 + i) * 1536 + c;
      *q = f2bf(bf2f(*q) * acc[i]);
    }
  }
}

DI void phase_mixers(const P& p, int l, unsigned char* smem, int* s_item) {
  unsigned* ctr = (unsigned*)(p.ws + OFF_CTR) + l;
  const int n_mla = 1024, n_hy = 512, n_swa = 1024;
  const int n_cm = (l == 0) ? 32 : 0, n_cs = (l == 0) ? 32 : 0, n_ch = (l == 0) ? 64 : 0;
  const int c0 = n_ch, c1 = c0 + n_cm, c2 = c1 + n_cs;
  const int e0 = c2 + n_mla, e1 = e0 + n_hy, e2 = e1 + n_swa;
  for (;;) {
    __syncthreads();
    if (tidx() == 0) *s_item = (int)atomicAdd(ctr, 1u);
    __syncthreads();
    int item = *s_item;
    if (item >= e2) break;
    if (item < c0) {
      hyena_ctx_item(p, item);
    } else if (item < c1) {
      int it = item - c0;
      mla_item(p, it >> 4, (it >> 1) & 7, it & 1, true, smem);
    } else if (item < c2) {
      int it = item - c1;
      swa_item(p, l, it >> 4, (it >> 1) & 7, it & 1, true, smem);
    } else if (item < e0) {
      int it = item - c2;
      mla_item(p, it >> 9, (it >> 6) & 7, it & 63, false, smem);
    } else if (item < e1) {
      hyena_item(p, item - e0, smem);
    } else {
      int it = item - e1;
      swa_item(p, l, it >> 9, (it >> 6) & 7, it & 63, false, smem);
    }
  }
}

DI void phase_mixers_dry(const P& p, int l, unsigned char* smem, int kind) {
  if (kind == 1) {
    for (int item = blockIdx.x; item < 1024; item += gridDim.x) mla_item(p, item >> 9, (item >> 6) & 7, item & 63, false, smem, true);
  } else if (kind == 2) {
    for (int item = blockIdx.x; item < 512; item += gridDim.x) hyena_item(p, item, smem, true);
  } else {
    for (int item = blockIdx.x; item < 1024; item += gridDim.x) swa_item(p, l, item >> 9, (item >> 6) & 7, item & 63, false, smem, true);
  }
}

DI void phase_merge(const P& p, int l, unsigned char* smem) {
  const bf16_t* U = (const bf16_t*)(p.ws + OFF_U);
  const bf16_t* Wmg = (const bf16_t*)(p.ws + OFF_W + WOFF_IN) + (size_t)N1 * 1024;
  const bf16_t* Wp = (const bf16_t*)(p.ws + OFF_W + WOFF_P);
  const bf16_t* Y = (const bf16_t*)(p.ws + OFF_GATE);
  bf16_t* M = (bf16_t*)(p.ws + OFF_M);
  const int lane = tidx() & 63, wave = tidx() >> 6;
  const int r = lane & 31, h = lane >> 5, wn = wave & 1, wm = wave >> 1;
  const int nm = (l == 0) ? R_ALL / 128 : R_LAT / 128;
  const int spx = gridDim.x >> 3;
  const int xcd = blockIdx.x & 7, slot = blockIdx.x >> 3;
  const int pair = xcd & 3, mhalf = xcd >> 2, nmh = (R_LAT / 128) >> 1;
  const bf16_t* SGC = (const bf16_t*)(p.ws + OFF_SGC);
  const int nctx = (l == 0) ? 4 : 0;
  const int nlat = nmh * 2;
  for (int k = 0; k * spx < nlat + nctx + spx - 1; ++k) {
    int j = k * spx + slot;
    int jj = j;
    bool isc = false;
    if (jj >= nlat) {
      int base = ((nlat + spx - 1) / spx) * spx;
      if (j < base || j >= base + nctx) continue;
      jj = j - base;
      isc = true;
    }
    int mtile, ntile;
    if (!isc) { mtile = mhalf * nmh + (jj >> 1); ntile = 2 * pair + (jj & 1); }
    else { mtile = R_LAT / 128 + 2 * mhalf + (jj >> 1); ntile = 2 * pair + (jj & 1); }
    unsigned msum[2][2][8];
#pragma unroll
    for (int i = 0; i < 2; ++i)
#pragma unroll
      for (int j = 0; j < 2; ++j)
#pragma unroll
        for (int k = 0; k < 8; ++k) msum[i][j][k] = 0u;
#pragma unroll 1
    for (int br = 0; br < 3; ++br) {
      f32x16 acc[2][2];
      unsigned sg[2][2][8];
      if (!isc) {
        zero_acc(acc);
        gemm_core(Wmg + (size_t)(br * 1024 + ntile * 128) * 1024, 1024, U + (size_t)mtile * 128 * 1024, 1024, 1024, acc, smem);
#pragma unroll
        for (int i = 0; i < 2; ++i)
#pragma unroll
          for (int j = 0; j < 2; ++j)
#pragma unroll
            for (int k = 0; k < 8; ++k) sg[i][j][k] = pk2(sigm_f(acc[i][j][2 * k]), sigm_f(acc[i][j][2 * k + 1]));
      } else {
#pragma unroll
        for (int i = 0; i < 2; ++i)
#pragma unroll
          for (int j = 0; j < 2; ++j) {
            int mrow = mtile * 128 + wm * 64 + j * 32 + r - R_LAT;
            const bf16_t* gp = SGC + (size_t)mrow * 3072 + br * 1024 + ntile * 128 + wn * 64 + i * 32 + 4 * h;
#pragma unroll
            for (int g = 0; g < 4; ++g) {
              uint2 v = *(const uint2*)(gp + 8 * g);
              sg[i][j][2 * g] = v.x;
              sg[i][j][2 * g + 1] = v.y;
            }
          }
      }
      zero_acc(acc);
      gemm_core(Wp + (size_t)(br * 1024 + ntile * 128) * 512, 512, Y + (size_t)mtile * 128 * 1536 + br * 512, 1536, 512, acc, smem);
#pragma unroll
      for (int i = 0; i < 2; ++i)
#pragma unroll
        for (int j = 0; j < 2; ++j)
#pragma unroll
          for (int k = 0; k < 8; ++k) {
            float lo = bflo(msum[i][j][k]) + bflo(sg[i][j][k]) * acc[i][j][2 * k];
            float hi = bfhi(msum[i][j][k]) + bfhi(sg[i][j][k]) * acc[i][j][2 * k + 1];
            msum[i][j][k] = pk2(lo, hi);
          }
    }
#pragma unroll
    for (int mt = 0; mt < 2; ++mt) {
      int m = mtile * 128 + wm * 64 + mt * 32 + r;
#pragma unroll
      for (int nt = 0; nt < 2; ++nt) {
        int n = ntile * 128 + wn * 64 + nt * 32 + 4 * h;
#pragma unroll
        for (int g = 0; g < 4; ++g) {
          uint2 o = {msum[nt][mt][2 * g], msum[nt][mt][2 * g + 1]};
          *(uint2*)(M + (size_t)m * 1024 + n + 8 * g) = o;
        }
      }
    }
  }
}

DI void phase_out(const P& p, int l, unsigned char* smem) {
  const bf16_t* M = (const bf16_t*)(p.ws + OFF_M);
  const bf16_t* Wo = (const bf16_t*)(p.ws + OFF_W + WOFF_OUT);
  const float* mod = (const float*)(p.ws + OFF_MOD) + (size_t)l * 3 * 3072;
  float* zc = (float*)(p.ws + OFF_ZC);
  const int lane = tidx() & 63, wave = tidx() >> 6;
  const int r = lane & 31, h = lane >> 5, wn = wave & 1, wm = wave >> 1;
  const int nm = (l == 0) ? R_ALL / 128 : R_LAT / 128;
  const float ALPHA = 1.4142135623730951f;
  for (int k = 0; k * (int)gridDim.x < nm * 8; ++k) {
    int item = xcd_item(k);
    if (item >= nm * 8) continue;
    int mtile = item >> 3, ntile = item & 7;
    f32x16 acc[2][2];
    zero_acc(acc);
    gemm_core<true>(Wo + (size_t)ntile * 128 * 1024, 1024, M + (size_t)mtile * 128 * 1024, 1024, 1024, acc, smem);
#pragma unroll
    for (int mt = 0; mt < 2; ++mt) {
      int m = mtile * 128 + wm * 64 + mt * 32 + r;
      const float* xin;
      float* dst;
      int v;
      if (m < R_LAT) {
        xin = (l == 0 ? p.x : p.out) + (size_t)m * 1024;
        dst = p.out + (size_t)m * 1024;
        v = m >> 13;
      } else {
        xin = p.ctx + (size_t)(m - R_LAT) * 1024;
        dst = zc + (size_t)(m - R_LAT) * 1024;
        v = 2;
      }
      const float* gate = mod + (size_t)v * 3072 + 2048;
      float4 xv[2][4], gv[2][4];
#pragma unroll
      for (int nt = 0; nt < 2; ++nt) {
        int n = ntile * 128 + wn * 64 + nt * 32 + 4 * h;
#pragma unroll
        for (int g = 0; g < 4; ++g) {
          xv[nt][g] = *(const float4*)(xin + n + 8 * g);
          gv[nt][g] = *(const float4*)(gate + n + 8 * g);
        }
      }
#pragma unroll
      for (int nt = 0; nt < 2; ++nt) {
        int n = ntile * 128 + wn * 64 + nt * 32 + 4 * h;
#pragma unroll
        for (int g = 0; g < 4; ++g) {
          f32x16& a = acc[nt][mt];
          float4 o;
          o.x = ALPHA * xv[nt][g].x + gv[nt][g].x * a[4 * g];
          o.y = ALPHA * xv[nt][g].y + gv[nt][g].y * a[4 * g + 1];
          o.z = ALPHA * xv[nt][g].z + gv[nt][g].z * a[4 * g + 2];
          o.w = ALPHA * xv[nt][g].w + gv[nt][g].w * a[4 * g + 3];
          *(float4*)(dst + n + 8 * g) = o;
        }
      }
    }
  }
}

DI void phase_prep(const P& p, int l, unsigned char* smem) {
  if (blockIdx.x == 0 && tidx() == 0) ((unsigned*)(p.ws + OFF_CTR))[l] = 0u;
  const int nlat = S_LAT / 16, nctx = (l == 0) ? LC / 16 : 0;
  for (int item = blockIdx.x; item < nlat; item += gridDim.x) filter_item(p, l, S_LAT, item * 16, false, smem);
  for (int item = (int)gridDim.x - 1 - (int)blockIdx.x; item < nctx; item += gridDim.x) filter_item(p, l, LC, item * 16, true, smem);
  phase_convert(p, l, smem);
}

constexpr int NPHASE = 17;

__global__ void __launch_bounds__(256, 2) mega(P p) {
  __shared__ __attribute__((aligned(16))) unsigned char smem[73728];
  __shared__ float rs[128];
  __shared__ int s_item;
  cg::grid_group grid = cg::this_grid();
  if (p.phase_lo < 0) grid.sync();
  __shared__ uint4 xb_words;
  if (threadIdx.x == 0) xb_words = make_uint4(0u, 0u, 0u, 0u);
  __syncthreads();
  XcdBarrier xb = xcd_barrier_post((unsigned*)(p.ws + OFF_BAR), (volatile LAS unsigned*)&xb_words);
  for (int ph = p.phase_lo; ph < p.phase_hi; ++ph) {
#ifndef PH_MASK
#define PH_MASK 0x1ff
#endif
    if (ph == 0) {
      if (PH_MASK & 0x100) { phase_mod(p, smem); phase_prep(p, 0, smem); }
    } else {
      int l = (ph - 1) >> 3, sub = (ph - 1) & 7;
      switch (sub) {
#ifndef EXP
#define EXP 0
#endif
        case 0: if (PH_MASK & 1) { if (l == 0) phase_ln0(p); } break;
        case 1: if (PH_MASK & 2) { phase_gemm1(p, l, smem); } break;
        case 2: if (PH_MASK & 4) { phase_hyprep(p, l, smem);  } break;
        case 3: if (PH_MASK & 8) { phase_upproj(p, l, smem, rs); } break;
        case 4: if (PH_MASK & 16) { phase_mixers(p, l, smem, &s_item); } break;
        case 5: if (PH_MASK & 32) { phase_merge(p, l, smem); } break;
        case 6: if (PH_MASK & 64) { phase_out(p, l, smem); } break;
        case 7: if (PH_MASK & 128) { phase_lnG(p, l); if (l == 0) phase_prep(p, 1, smem); } break;
      }
    }
    if (ph + 1 < p.phase_hi && ph != 9) { xcd_barrier(xb); }
  }
}

extern "C" void kernel_launch(void* const* d_in, const int* in_sizes, int n_in, void* d_out, int out_size, void* d_ws,
                              size_t ws_size, hipStream_t stream) {
  static int grid_blocks = 0;
  if (!grid_blocks) {
    int dev = 0, cus = 0, per_cu = 0;
    hipGetDevice(&dev);
    hipDeviceGetAttribute(&cus, hipDeviceAttributeMultiprocessorCount, dev);
    hipOccupancyMaxActiveBlocksPerMultiprocessor(&per_cu, mega, 256, 0);
    if (per_cu < 1) per_cu = 1;
    if (per_cu > 2) per_cu = 2;
    grid_blocks = cus * per_cu;
  }
  P p;
  memset(&p, 0, sizeof(p));
  const float** f = (const float**)&p;
  for (int i = 0; i < 29; ++i) f[i] = (const float*)d_in[i];
  p.out = (float*)d_out;
  p.ws = (char*)d_ws;
#if MULTI_LAUNCH
  for (int ph = 0; ph < NPHASE; ++ph) {
    p.phase_lo = ph;
    p.phase_hi = ph + 1;
    hipLaunchKernelGGL(mega, dim3(grid_blocks), dim3(256), 0, stream, p);
  }
#else
  p.phase_lo = 0;
  p.phase_hi = NPHASE;
  hipMemsetAsync((char*)d_ws + OFF_CTR, 0, 256 + 16384, stream);
  void* args[] = {&p};
  hipError_t e = hipLaunchCooperativeKernel((void*)mega, dim3(grid_blocks), dim3(256), args, 0, stream);
  if (e != hipSuccess) fprintf(stderr, "cooperative launch failed: %s (grid %d)\n", hipGetErrorString(e), grid_blocks);
#endif
}
```

```cpp
#include <hip/hip_runtime.h>
#include <hip/hip_cooperative_groups.h>
#include <stdint.h>
#include <stdio.h>
#include <string.h>
namespace cg = cooperative_groups;

#ifndef MULTI_LAUNCH
#define MULTI_LAUNCH 0
#endif

typedef __attribute__((ext_vector_type(8))) short bf16x8;
typedef __attribute__((ext_vector_type(16))) float f32x16;
typedef unsigned short bf16_t;
typedef __attribute__((ext_vector_type(4))) unsigned u32x4;
#define MKFRAG(a, b, c, d) __builtin_bit_cast(bf16x8, (u32x4){(a), (b), (c), (d)})
#define DI __device__ __forceinline__
#define MFMA(a, b, c) __builtin_amdgcn_mfma_f32_32x32x16_bf16((a), (b), (c), 0, 0, 0)

constexpr int S_LAT = 8192, LC = 256, DM = 1024;
constexpr int R_LAT = 16384, R_CTX = 512, R_ALL = 16896;
constexpr int NKEY = 8448;
constexpr int N1 = 4352;
constexpr int NWIN = 7424;
constexpr int P_TOTAL = 7328;

constexpr size_t SZ_U = (size_t)R_ALL * 1024 * 2;
constexpr size_t SZ_HY = (size_t)R_ALL * 1536 * 2;
constexpr size_t OFF_U = 0;
constexpr size_t OFF_HY = OFF_U + SZ_U;
constexpr size_t OFF_QN = OFF_HY;
constexpr size_t OFF_QR = OFF_QN + (size_t)R_ALL * 512 * 2;
constexpr size_t OFF_KN = OFF_QR + (size_t)R_ALL * 256 * 2;
constexpr size_t OFF_M = OFF_HY;
constexpr size_t OFF_GATE = OFF_HY + SZ_HY;
constexpr size_t OFF_CQ = OFF_GATE + SZ_HY;
constexpr size_t OFF_CKV = OFF_CQ + (size_t)R_ALL * 256 * 2;
constexpr size_t OFF_KR = OFF_CKV + (size_t)R_ALL * 128 * 2;
constexpr size_t OFF_SQ = OFF_KR + (size_t)R_ALL * 32 * 2;
constexpr size_t OFF_SK = OFF_SQ + (size_t)R_ALL * 512 * 2;
constexpr size_t OFF_SVT = OFF_SK + (size_t)R_ALL * 128 * 2;
constexpr size_t OFF_VTM = OFF_SVT + (size_t)2 * 2 * 64 * NKEY * 2;
constexpr size_t OFF_UT = OFF_VTM + (size_t)2 * 8 * 64 * NKEY * 2;
constexpr size_t OFF_UC = OFF_UT + (size_t)512 * 16384 * 2;
constexpr size_t OFF_W = OFF_UC + (size_t)512 * 512 * 4;
constexpr size_t WOFF_IN = 0;
constexpr size_t WOFF_UQ = WOFF_IN + (size_t)NWIN * 1024 * 2;
constexpr size_t WOFF_UKV = WOFF_UQ + (size_t)768 * 256 * 2;
constexpr size_t WOFF_P = WOFF_UKV + (size_t)1024 * 128 * 2;
constexpr size_t WOFF_OUT = WOFF_P + (size_t)3 * 1024 * 512 * 2;
constexpr size_t SZ_W = WOFF_OUT + (size_t)1024 * 1024 * 2;
constexpr size_t OFF_FG = OFF_W + SZ_W;
constexpr size_t OFF_FC = OFF_FG + (size_t)512 * 16384 * 2;
constexpr size_t OFF_MOD = OFF_FC + (size_t)512 * 512 * 4;
constexpr size_t OFF_ZC = OFF_MOD + (size_t)2 * 3 * 3072 * 4;
constexpr size_t OFF_CTR = OFF_ZC + (size_t)512 * 1024 * 4;
constexpr size_t OFF_BAR = OFF_CTR + 256;
constexpr size_t OFF_SGC = OFF_BAR + 16384;
constexpr size_t WS_TOTAL = OFF_SGC + (size_t)R_CTX * 3072 * 2;
static_assert(WS_TOTAL <= (size_t)256 * 1024 * 1024, "workspace too large");
static_assert(OFF_KN + (size_t)R_ALL * 512 * 2 <= OFF_GATE, "alias overflow");

struct P {
  const float *x, *c, *ctx, *c_ctx, *w_ada, *b_ada, *w_in, *hy_conv_w, *hy_conv_b;
  const float *fw1, *fb1, *fw2, *fb2, *fw3, *fb3, *ffreq, *fwout, *hy_skip;
  const float *q_norm, *w_uq, *kv_norm, *w_ukv, *sink, *wp_hy, *wp_mla, *wp_swa, *w_out, *ln_g, *ln_b;
  float* out;
  char* ws;
  int phase_lo, phase_hi;
};

DI int tidx() { int t = __builtin_amdgcn_workitem_id_x(); asm volatile("" : "+v"(t)); return t; }
DI float bf2f(unsigned short v) { return __uint_as_float(((unsigned)v) << 16); }
DI float bflo(unsigned v) { return __uint_as_float(v << 16); }
DI float bfhi(unsigned v) { return __uint_as_float(v & 0xffff0000u); }
typedef float f32x2_t __attribute__((ext_vector_type(2)));
typedef __bf16 bf16x2_t __attribute__((ext_vector_type(2)));
DI unsigned pk2(float lo, float hi) {
  f32x2_t v = {lo, hi};
  bf16x2_t b = __builtin_convertvector(v, bf16x2_t);
  return __builtin_bit_cast(unsigned, b);
}
DI unsigned short f2bf(float v) { return (unsigned short)(pk2(v, 0.f) & 0xffffu); }
DI float silu_f(float v) { return v / (1.f + __expf(-v)); }
DI float sigm_f(float v) { return 1.f / (1.f + __expf(-v)); }
DI float wave_sum(float v) {
#pragma unroll
  for (int o = 32; o >= 1; o >>= 1) v += __shfl_xor(v, o);
  return v;
}

#define GL1(V, PTR, LD, KT, P) V = *(const uint4*)((PTR) + (size_t)(rw + 32 * (P)) * (LD) + (KT) * 64 + c8 * 8)
#define G_LOAD(S, KT)                                                                     \
  GL1(S##w0, Wt, ldw, KT, 0); GL1(S##w1, Wt, ldw, KT, 1); GL1(S##w2, Wt, ldw, KT, 2); GL1(S##w3, Wt, ldw, KT, 3); \
  GL1(S##x0, X, ldx, KT, 0);  GL1(S##x1, X, ldx, KT, 1);  GL1(S##x2, X, ldx, KT, 2);  GL1(S##x3, X, ldx, KT, 3)
#define GS1(V, BASE, P) *(uint4*)((BASE) + (rw + 32 * (P)) * 72 + (c8 << 3)) = V
#define G_STORE(S, BUF)                                                                   \
  GS1(S##w0, sW + (BUF) * 9216, 0); GS1(S##w1, sW + (BUF) * 9216, 1); GS1(S##w2, sW + (BUF) * 9216, 2); GS1(S##w3, sW + (BUF) * 9216, 3); \
  GS1(S##x0, sX + (BUF) * 9216, 0); GS1(S##x1, sX + (BUF) * 9216, 1); GS1(S##x2, sX + (BUF) * 9216, 2); GS1(S##x3, sX + (BUF) * 9216, 3)
DI void g_compute(const bf16_t* cw, const bf16_t* cx, f32x16 (&acc)[2][2]) {
  __builtin_amdgcn_s_setprio(1);
#pragma unroll
  for (int ks = 0; ks < 4; ++ks) {
    bf16x8 a[2], b[2];
#pragma unroll
    for (int i = 0; i < 2; ++i) {
      a[i] = *(const bf16x8*)(cw + i * 32 * 72 + ks * 16);
      b[i] = *(const bf16x8*)(cx + i * 32 * 72 + ks * 16);
    }
#pragma unroll
    for (int i = 0; i < 2; ++i)
#pragma unroll
      for (int j = 0; j < 2; ++j) acc[i][j] = MFMA(a[i], b[j], acc[i][j]);
  }
  __builtin_amdgcn_s_setprio(0);
}

template <bool TWO = false>
DI void gemm_core(const bf16_t* __restrict__ Wt, int ldw, const bf16_t* __restrict__ X, int ldx, int K,
                  f32x16 (&acc)[2][2], unsigned char* smem) {
  const int tid = tidx();
  const int lane = tid & 63, wave = tid >> 6;
  const int r = lane & 31, h = lane >> 5;
  const int wn = wave & 1, wm = wave >> 1;
  const int c8 = tid & 7, rw = tid >> 3;
  bf16_t* sW = (bf16_t*)smem;
  bf16_t* sX = (bf16_t*)(smem + 36864);
  const bf16_t* cw = sW + (wn * 64 + r) * 72 + h * 8;
  const bf16_t* cx = sX + (wm * 64 + r) * 72 + h * 8;
  if constexpr (TWO) {
  uint4 ew0, ew1, ew2, ew3, ex0, ex1, ex2, ex3, ow0, ow1, ow2, ow3, ox0, ox1, ox2, ox3;
  const int nk = K >> 6;
  G_LOAD(e, 0);
  G_LOAD(o, 1);
  __syncthreads();
  G_STORE(e, 0);
  if (nk > 2) { G_LOAD(e, 2); }
  __syncthreads();
  for (int kt = 0; kt < nk; kt += 2) {
    g_compute(cw, cx, acc);
    G_STORE(o, 1);
    if (kt + 3 < nk) { G_LOAD(o, kt + 3); }
    __syncthreads();
    g_compute(cw + 9216, cx + 9216, acc);
    if (kt + 2 < nk) {
      G_STORE(e, 0);
      if (kt + 4 < nk) { G_LOAD(e, kt + 4); }
    }
    __syncthreads();
  }
  } else {
  uint4 ew0, ew1, ew2, ew3, ex0, ex1, ex2, ex3;
  const int nk = K >> 6;
  {
    uint4 ow0, ow1, ow2, ow3, ox0, ox1, ox2, ox3;
    G_LOAD(e, 0);
    G_LOAD(o, 1);
    __syncthreads();
    G_STORE(e, 0);
    if (nk > 2) { G_LOAD(e, 2); }
    __syncthreads();
    G_STORE(o, 1);
    g_compute(cw, cx, acc);
    __syncthreads();
  }
#pragma unroll 1
  for (int kt = 1; kt < nk; ++kt) {
    const int cur = kt & 1;
    if (kt + 1 < nk) { G_STORE(e, cur ^ 1); }
    if (kt + 2 < nk) { G_LOAD(e, kt + 2); }
    g_compute(cw + cur * 9216, cx + cur * 9216, acc);
    __syncthreads();
  }
  }
}

DI void zero_acc(f32x16 (&acc)[2][2]) {
#pragma unroll
  for (int i = 0; i < 2; ++i)
#pragma unroll
    for (int j = 0; j < 2; ++j)
#pragma unroll
      for (int k = 0; k < 16; ++k) acc[i][j][k] = 0.f;
}

#define XB_TMO      128
#define XB_XCNT(j)  (256  + 64 * (j))
#define XB_XSUB(j)  (1280 + 64 * (j))
#define XB_XGEN(j)  (2304 + 64 * (j))
#define XB_TOP      3328
#define XB_TOPGEN   3392
#define XCD_BAR_WORDS 3456
#define XB_SPIN_CAP (1u << 18)
#define LAS __attribute__((address_space(3)))

__device__ __forceinline__ unsigned xb_ld(unsigned* p)              { return __hip_atomic_load(p, __ATOMIC_RELAXED, __HIP_MEMORY_SCOPE_AGENT); }
__device__ __forceinline__ unsigned xb_add(unsigned* p, unsigned v) { return __hip_atomic_fetch_add(p, v, __ATOMIC_RELAXED, __HIP_MEMORY_SCOPE_AGENT); }
__device__ __forceinline__ unsigned xb_xcc_id() { return (unsigned)__builtin_amdgcn_s_getreg((3 << 11) | 20) & 0xFu; }
#define XB_SPIN(cond, bar) do { unsigned _sp = 0; while (cond) { __builtin_amdgcn_s_sleep(1); \
    if ((++_sp & 255u) == 0u) { if (xb_ld(&(bar)[XB_TMO])) break; if (_sp > XB_SPIN_CAP) { atomicAdd(&(bar)[XB_TMO], 1u); break; } } } } while (0)

struct XcdBarrier {
    unsigned* bar; unsigned x;
    volatile LAS unsigned* st;
};

__device__ __forceinline__ XcdBarrier xcd_barrier_post(unsigned* bar, volatile LAS unsigned* st) {
    XcdBarrier b; b.bar = bar; b.x = xb_xcc_id(); b.st = st;
    if (threadIdx.x == 0) (void)xb_add(&bar[XB_XCNT(b.x)], 1u);
    return b;
}
__device__ __forceinline__ void xcd_barrier_complete(unsigned* bar, unsigned x, unsigned& nloc, unsigned& nx) {
    const unsigned G = gridDim.x * gridDim.y * gridDim.z;
    unsigned sum, cnt, mine, sp = 0u;
    for (;;) {
        sum = 0u; cnt = 0u; mine = 0u;
#pragma unroll
        for (unsigned j = 0; j < 16; ++j) { const unsigned c = xb_ld(&bar[XB_XCNT(j)]); sum += c; cnt += (c > 0u) ? 1u : 0u; mine = (j == x) ? c : mine; }
        if (sum == G) break;
        __builtin_amdgcn_s_sleep(1);
        if ((++sp & 255u) == 0u) { if (xb_ld(&bar[XB_TMO])) break; if (sp > XB_SPIN_CAP) { atomicAdd(&bar[XB_TMO], 1u); break; } }
    }
    nloc = mine > 0u ? mine : 1u; nx = cnt > 0u ? cnt : 1u;
}

__device__ __forceinline__ void xcd_barrier(const XcdBarrier& b) {
    asm volatile("s_waitcnt vmcnt(0)" ::: "memory");
    __syncthreads();
    if (threadIdx.x == 0) {
        unsigned* bar = b.bar;
        __builtin_amdgcn_s_waitcnt(0);
        unsigned nloc = b.st[0], nx = b.st[1];
        if (nloc == 0u) { xcd_barrier_complete(bar, b.x, nloc, nx); b.st[0] = nloc; b.st[1] = nx; }
        const unsigned old = xb_add(&bar[XB_XSUB(b.x)], 1u);
        const unsigned gen = old / nloc;
        if (old + 1u == (gen + 1u) * nloc) {
            __builtin_amdgcn_fence(__ATOMIC_RELEASE, "agent");
            asm volatile("s_waitcnt vmcnt(0)" ::: "memory");
            const unsigned og = xb_add(&bar[XB_TOP], 1u);
            const unsigned tg = og / nx;
            if (og + 1u == (tg + 1u) * nx) xb_add(&bar[XB_TOPGEN], 1u);
            else XB_SPIN(xb_ld(&bar[XB_TOPGEN]) == tg, bar);
            __builtin_amdgcn_fence(__ATOMIC_ACQUIRE, "agent");
            xb_add(&bar[XB_XGEN(b.x)], 1u);
            asm volatile("s_waitcnt vmcnt(0)" ::: "memory");
        } else {
            XB_SPIN(xb_ld(&bar[XB_XGEN(b.x)]) == gen, bar);
            __builtin_amdgcn_fence(__ATOMIC_ACQUIRE, "agent");
            asm volatile("s_waitcnt vmcnt(0)" ::: "memory");
        }
    }
    __syncthreads();
}


DI void grid_bar(unsigned* bar, unsigned target) {
  __syncthreads();
  if (tidx() == 0) {
    __threadfence();
    __hip_atomic_fetch_add(bar, 1u, __ATOMIC_RELAXED, __HIP_MEMORY_SCOPE_AGENT);
    while (__hip_atomic_load(bar, __ATOMIC_RELAXED, __HIP_MEMORY_SCOPE_AGENT) < target) __builtin_amdgcn_s_sleep(1);
    __threadfence();
  }
  __syncthreads();
}
DI int xcd_item(int k) {
  int nb = gridDim.x, b = blockIdx.x;
  return k * nb + (b & 7) * (nb >> 3) + (b >> 3);
}

struct RowInfo { int isctx, b, prow, pcol, kidx; };
DI RowInfo row_info(int m) {
  RowInfo ri;
  if (m < R_LAT) {
    int t = m & (S_LAT - 1);
    ri.isctx = 0; ri.b = m >> 13; ri.prow = t >> 6; ri.pcol = t & 63; ri.kidx = LC + t;
  } else {
    int i = m - R_LAT;
    ri.isctx = 1; ri.b = i >> 8; ri.prow = 0; ri.pcol = 0; ri.kidx = i & 255;
  }
  return ri;
}

DI void phase_mod(const P& p, unsigned char* smem) {
  float* red = (float*)smem;
  float* sc = (float*)(smem + 4096);
  float* mod = (float*)(p.ws + OFF_MOD);
  const int t = tidx();
  if (blockIdx.x < 192) {
    for (int i = t; i < 3072; i += 256) {
      float v = (i < 2048) ? p.c[i] : p.c_ctx[i - 2048];
      sc[i] = silu_f(v);
    }
    __syncthreads();
  }
  for (int item = blockIdx.x; item < 192; item += gridDim.x) {
    int l = item / 96, j0 = (item % 96) * 32;
    int col = j0 + (t & 31), kq = t >> 5;
    const float* w = p.w_ada + (size_t)l * 1024 * 3072;
    float a0 = 0.f, a1 = 0.f, a2 = 0.f;
#pragma unroll 1
    for (int k0 = kq * 128; k0 < kq * 128 + 128; k0 += 32) {
      float wr[32];
#pragma unroll
      for (int k = 0; k < 32; ++k) wr[k] = w[(size_t)(k0 + k) * 3072 + col];
#pragma unroll
      for (int k = 0; k < 32; ++k) {
        a0 += sc[k0 + k] * wr[k];
        a1 += sc[1024 + k0 + k] * wr[k];
        a2 += sc[2048 + k0 + k] * wr[k];
      }
    }
    __syncthreads();
    red[(0 * 8 + kq) * 32 + (t & 31)] = a0;
    red[(1 * 8 + kq) * 32 + (t & 31)] = a1;
    red[(2 * 8 + kq) * 32 + (t & 31)] = a2;
    __syncthreads();
    if (t < 96) {
      int v = t >> 5, cc = t & 31;
      float s = 0.f;
#pragma unroll
      for (int q = 0; q < 8; ++q) s += red[(v * 8 + q) * 32 + cc];
      mod[(size_t)(l * 3 + v) * 3072 + j0 + cc] = s + p.b_ada[(size_t)l * 3072 + j0 + cc];
    }
  }
}

DI void convert_tile(const float* __restrict__ src, int ldsrc, int c0, int ncols, int K, bf16_t* __restrict__ dst,
                     const float* __restrict__ kscale, int it, unsigned char* smem) {
  float* tile = (float*)smem;
  const int t = tidx();
  const int tx = t & 15, ty = t >> 4;
  const int wn = t >> 2, wk = (t & 3) * 16;
  const int tk = K >> 6;
  int k0 = (it % tk) * 64, n0 = (it / tk) * 64;
  float4 v[4];
  bool okl = (n0 + 4 * tx) < ncols;
#pragma unroll
  for (int i = 0; i < 4; ++i) {
    int kk = ty + 16 * i;
    v[i] = okl ? *(const float4*)(src + (size_t)(k0 + kk) * ldsrc + c0 + n0 + 4 * tx) : make_float4(0.f, 0.f, 0.f, 0.f);
    if (kscale) { float sc = kscale[k0 + kk]; v[i].x *= sc; v[i].y *= sc; v[i].z *= sc; v[i].w *= sc; }
  }
  __syncthreads();
#pragma unroll
  for (int i = 0; i < 4; ++i) {
    int kk = ty + 16 * i;
    tile[kk * 65 + 4 * tx + 0] = v[i].x;
    tile[kk * 65 + 4 * tx + 1] = v[i].y;
    tile[kk * 65 + 4 * tx + 2] = v[i].z;
    tile[kk * 65 + 4 * tx + 3] = v[i].w;
  }
  __syncthreads();
  if (n0 + wn < ncols) {
    unsigned o[8];
#pragma unroll
    for (int j = 0; j < 8; ++j) o[j] = pk2(tile[(wk + 2 * j) * 65 + wn], tile[(wk + 2 * j + 1) * 65 + wn]);
    uint4* d = (uint4*)(dst + (size_t)(n0 + wn) * K + k0 + wk);
    d[0] = make_uint4(o[0], o[1], o[2], o[3]);
    d[1] = make_uint4(o[4], o[5], o[6], o[7]);
  }
}

struct CJob { int src, ld, c0, ncols, K; unsigned dst; int sc; };
#define WIN_E(r) ((unsigned)(WOFF_IN / 2) + (unsigned)(r) * 1024u)
#define WUQ_E(r) ((unsigned)(WOFF_UQ / 2) + (unsigned)(r) * 256u)
__device__ const CJob cjobs[32] = {
    {0, P_TOTAL, 0, 1536, 1024, WIN_E(0), 0},       {0, P_TOTAL, 1536, 512, 1024, WIN_E(1536), 0},
    {0, P_TOTAL, 2464, 512, 1024, WIN_E(2048), 0},  {0, P_TOTAL, 3744, 512, 1024, WIN_E(2560), 0},
    {0, P_TOTAL, 2048, 256, 1024, WIN_E(3072), 0},  {0, P_TOTAL, 2304, 128, 1024, WIN_E(3328), 0},
    {0, P_TOTAL, 2976, 512, 1024, WIN_E(3456), 0},  {0, P_TOTAL, 3488, 128, 1024, WIN_E(3968), 0},
    {0, P_TOTAL, 3616, 128, 1024, WIN_E(4096), 0},  {0, P_TOTAL, 2432, 32, 1024, WIN_E(4224), 0},
    {0, P_TOTAL, 4256, 3072, 1024, WIN_E(4352), 0},
    {1, 768, 0, 64, 256, WUQ_E(0), 1},     {1, 768, 64, 32, 256, WUQ_E(512), 1},
    {1, 768, 96, 64, 256, WUQ_E(64), 1},   {1, 768, 160, 32, 256, WUQ_E(544), 1},
    {1, 768, 192, 64, 256, WUQ_E(128), 1}, {1, 768, 256, 32, 256, WUQ_E(576), 1},
    {1, 768, 288, 64, 256, WUQ_E(192), 1}, {1, 768, 352, 32, 256, WUQ_E(608), 1},
    {1, 768, 384, 64, 256, WUQ_E(256), 1}, {1, 768, 448, 32, 256, WUQ_E(640), 1},
    {1, 768, 480, 64, 256, WUQ_E(320), 1}, {1, 768, 544, 32, 256, WUQ_E(672), 1},
    {1, 768, 576, 64, 256, WUQ_E(384), 1}, {1, 768, 640, 32, 256, WUQ_E(704), 1},
    {1, 768, 672, 64, 256, WUQ_E(448), 1}, {1, 768, 736, 32, 256, WUQ_E(736), 1},
    {2, 1024, 0, 1024, 128, (unsigned)(WOFF_UKV / 2), 2},
    {3, 1024, 0, 1024, 512, (unsigned)(WOFF_P / 2), 0},
    {4, 1024, 0, 1024, 512, (unsigned)(WOFF_P / 2) + 1024u * 512u, 0},
    {5, 1024, 0, 1024, 512, (unsigned)(WOFF_P / 2) + 2u * 1024u * 512u, 0},
    {6, 1024, 0, 1024, 1024, (unsigned)(WOFF_OUT / 2), 0}};

DI void phase_convert(const P& p, int l, unsigned char* smem) {
  bf16_t* W = (bf16_t*)(p.ws + OFF_W);
  for (int i = blockIdx.x * 256 + tidx(); i < 96 * 1024 / 2; i += gridDim.x * 256)
    ((unsigned*)(W + WOFF_IN / 2 + (size_t)4256 * 1024))[i] = 0u;
  int g = blockIdx.x;
  int base = 0;
#pragma unroll 1
  for (int j = 0; j < 32; ++j) {
    CJob jb = cjobs[j];
    int nt = (jb.K >> 6) * ((jb.ncols + 63) >> 6);
    const float* src;
    switch (jb.src) {
      case 0: src = p.w_in + (size_t)l * 1024 * P_TOTAL; break;
      case 1: src = p.w_uq + (size_t)l * 256 * 768; break;
      case 2: src = p.w_ukv + (size_t)l * 128 * 1024; break;
      case 3: src = p.wp_hy + (size_t)l * 512 * 1024; break;
      case 4: src = p.wp_mla + (size_t)l * 512 * 1024; break;
      case 5: src = p.wp_swa + (size_t)l * 512 * 1024; break;
      default: src = p.w_out + (size_t)l * 1024 * 1024; break;
    }
    const float* sc = jb.sc == 1 ? p.q_norm + (size_t)l * 256 : (jb.sc == 2 ? p.kv_norm + (size_t)l * 128 : nullptr);
    while (g < base + nt) {
      convert_tile(src, jb.ld, jb.c0, jb.ncols, jb.K, W + jb.dst, sc, g - base, smem);
      g += gridDim.x;
    }
    base += nt;
  }
}

DI void filter_item(const P& p, int l, int L, int p0, bool isctx, unsigned char* smem) {
  float* zf = (float*)smem;
  float* ha = zf + 16 * 33;
  float* hb = ha + 16 * 64;
  const int t = tidx();
  const float* w1 = p.fw1 + (size_t)l * 33 * 64;
  const float* b1 = p.fb1 + l * 64;
  const float* w2 = p.fw2 + (size_t)l * 64 * 64;
  const float* b2 = p.fb2 + l * 64;
  const float* w3 = p.fw3 + (size_t)l * 64 * 64;
  const float* b3 = p.fb3 + l * 64;
  const float* fr = p.ffreq + l * 64;
  const float* wo = p.fwout + (size_t)l * 64 * 1024;
  __syncthreads();
  for (int i = t; i < 16 * 33; i += 256) {
    int pos = i / 33, f = i % 33;
    int pp = p0 + pos;
    float tt = (float)pp / (float)(L - 1);
    float wv = 6.283185307179586f * (float)pp / (float)L;
    float val;
    if (f == 0) val = tt;
    else {
      int j = (f - 1) & 15;
      float fq = 1e-4f + (float)j * ((15.f - 1e-4f) / 15.f);
      float ang = wv * fq;
      val = (f <= 16) ? __cosf(ang) : -__sinf(ang);
    }
    zf[pos * 33 + f] = val;
  }
  __syncthreads();
  const int unit = t & 63;
  const float fru = fr[unit];
  {
    float s4[4];
#pragma unroll
    for (int i = 0; i < 4; ++i) s4[i] = b1[unit];
#pragma unroll 1
    for (int f0 = 0; f0 < 33; f0 += 11) {
      float wr[11];
#pragma unroll
      for (int f = 0; f < 11; ++f) wr[f] = w1[(f0 + f) * 64 + unit];
#pragma unroll
      for (int f = 0; f < 11; ++f) {
#pragma unroll
        for (int i = 0; i < 4; ++i) s4[i] += zf[((t >> 6) + 4 * i) * 33 + f0 + f] * wr[f];
      }
    }
#pragma unroll
    for (int i = 0; i < 4; ++i) ha[((t >> 6) + 4 * i) * 64 + unit] = __sinf(fru * s4[i]);
  }
  __syncthreads();
  {
    float s4[4];
#pragma unroll
    for (int i = 0; i < 4; ++i) s4[i] = b2[unit];
#pragma unroll 1
    for (int f0 = 0; f0 < 64; f0 += 16) {
      float wr[16];
#pragma unroll
      for (int f = 0; f < 16; ++f) wr[f] = w2[(f0 + f) * 64 + unit];
#pragma unroll
      for (int f = 0; f < 16; ++f) {
#pragma unroll
        for (int i = 0; i < 4; ++i) s4[i] += ha[((t >> 6) + 4 * i) * 64 + f0 + f] * wr[f];
      }
    }
#pragma unroll
    for (int i = 0; i < 4; ++i) hb[((t >> 6) + 4 * i) * 64 + unit] = __sinf(fru * s4[i]);
  }
  __syncthreads();
  {
    float s4[4];
#pragma unroll
    for (int i = 0; i < 4; ++i) s4[i] = b3[unit];
#pragma unroll 1
    for (int f0 = 0; f0 < 64; f0 += 16) {
      float wr[16];
#pragma unroll
      for (int f = 0; f < 16; ++f) wr[f] = w3[(f0 + f) * 64 + unit];
#pragma unroll
      for (int f = 0; f < 16; ++f) {
#pragma unroll
        for (int i = 0; i < 4; ++i) s4[i] += hb[((t >> 6) + 4 * i) * 64 + f0 + f] * wr[f];
      }
    }
#pragma unroll
    for (int i = 0; i < 4; ++i) ha[unit * 16 + ((t >> 6) + 4 * i)] = __sinf(fru * s4[i]);
  }
  __syncthreads();
  const float min_decay = -3.0701134573253945f, max_decay = -15.350567286626973f;
  bf16_t* Fg = (bf16_t*)(p.ws + OFF_FG);
  float* Fc = (float*)(p.ws + OFF_FC);
  float* T = (float*)(smem + 12288);
#pragma unroll 1
  for (int dir = 0; dir < 2; ++dir) {
#pragma unroll 1
    for (int qq = 0; qq < 2; ++qq) {
      int ch = t + 256 * qq;
      int col = dir * 512 + ch;
      float acc[16];
#pragma unroll
      for (int i = 0; i < 16; ++i) acc[i] = 0.f;
#pragma unroll 1
      for (int k0 = 0; k0 < 64; k0 += 16) {
        float wr[16];
#pragma unroll
        for (int k = 0; k < 16; ++k) wr[k] = wo[(k0 + k) * 1024 + col];
#pragma unroll
        for (int k = 0; k < 16; ++k) {
#pragma unroll
          for (int i = 0; i < 16; ++i) acc[i] += ha[(k0 + k) * 16 + i] * wr[k];
        }
      }
      float delta = fabsf(min_decay + (max_decay - min_decay) * ((float)ch / 511.f));
      float skip = p.hy_skip[l * 512 + ch];
#pragma unroll
      for (int i = 0; i < 16; ++i) {
        int pp = p0 + i;
        float tt = (float)pp / (float)(L - 1);
        float v = acc[i] * __expf(-tt * delta);
        if (dir == 0 && pp == 0) v += skip;
        T[ch * 17 + i] = v;
      }
    }
    __syncthreads();
    for (int idx = t; idx < 8192; idx += 256) {
      int ch = idx >> 4, i = idx & 15;
      int pp = p0 + i;
      float v = T[ch * 17 + i];
      if (!isctx) {
        if (dir == 0) Fg[(size_t)ch * 16384 + (8192 - pp)] = f2bf(v);
        else if (pp == 0) Fg[(size_t)ch * 16384] = 0;
        else Fg[(size_t)ch * 16384 + 8192 + pp] = f2bf(v);
      } else {
        if (dir == 0) Fc[(size_t)(255 + pp) * 512 + ch] = v;
        else if (pp > 0) Fc[(size_t)(255 - pp) * 512 + ch] = v;
      }
    }
    __syncthreads();
  }
}

DI void ln_modulate_store(const float4 (&v)[4], const float* __restrict__ modv, bf16_t* __restrict__ urow, int lane) {
  float s = 0.f;
#pragma unroll
  for (int i = 0; i < 4; ++i) s += v[i].x + v[i].y + v[i].z + v[i].w;
  float mean = wave_sum(s) * (1.f / 1024.f);
  float q = 0.f;
#pragma unroll
  for (int i = 0; i < 4; ++i) {
    float a = v[i].x - mean, b = v[i].y - mean, c = v[i].z - mean, d = v[i].w - mean;
    q += a * a + b * b + c * c + d * d;
  }
  float rstd = rsqrtf(wave_sum(q) * (1.f / 1024.f) + 1e-6f);
#pragma unroll
  for (int i = 0; i < 4; ++i) {
    int col = 4 * lane + 256 * i;
    float4 sh = *(const float4*)(modv + col);
    float4 sc = *(const float4*)(modv + 1024 + col);
    float y0 = (v[i].x - mean) * rstd * (1.f + sc.x) + sh.x;
    float y1 = (v[i].y - mean) * rstd * (1.f + sc.y) + sh.y;
    float y2 = (v[i].z - mean) * rstd * (1.f + sc.z) + sh.z;
    float y3 = (v[i].w - mean) * rstd * (1.f + sc.w) + sh.w;
    uint2 o;
    o.x = pk2(y0, y1);
    o.y = pk2(y2, y3);
    *(uint2*)(urow + col) = o;
  }
}

DI void phase_ln0(const P& p) {
  const int lane = tidx() & 63, w = tidx() >> 6;
  bf16_t* U = (bf16_t*)(p.ws + OFF_U);
  const float* mod = (const float*)(p.ws + OFF_MOD);
  for (int item = blockIdx.x; item < R_ALL / 4; item += gridDim.x) {
    int row = item * 4 + w;
    const float* src = row < R_LAT ? p.x + (size_t)row * 1024 : p.ctx + (size_t)(row - R_LAT) * 1024;
    int v = row < R_LAT ? (row >> 13) : 2;
    float4 x[4];
#pragma unroll
    for (int i = 0; i < 4; ++i) x[i] = *(const float4*)(src + 4 * lane + 256 * i);
    ln_modulate_store(x, mod + (size_t)v * 3072, U + (size_t)row * 1024, lane);
  }
}

DI void phase_lnG(const P& p, int l) {
  const int lane = tidx() & 63, w = tidx() >> 6;
  bf16_t* U = (bf16_t*)(p.ws + OFF_U);
  const float* mod = (const float*)(p.ws + OFF_MOD) + (size_t)(l + 1) * 3 * 3072;
  const float* lg = p.ln_g + l * 1024;
  const float* lb = p.ln_b + l * 1024;
  float* zc = (float*)(p.ws + OFF_ZC);
  const int nrows = (l == 0) ? R_ALL : R_LAT;
  for (int item = blockIdx.x; item < nrows / 4; item += gridDim.x) {
    int row = item * 4 + w;
    float* src = row < R_LAT ? p.out + (size_t)row * 1024 : zc + (size_t)(row - R_LAT) * 1024;
    float4 x[4];
    float s = 0.f;
#pragma unroll
    for (int i = 0; i < 4; ++i) {
      x[i] = *(const float4*)(src + 4 * lane + 256 * i);
      s += x[i].x + x[i].y + x[i].z + x[i].w;
    }
    float mean = wave_sum(s) * (1.f / 1024.f);
    float q = 0.f;
#pragma unroll
    for (int i = 0; i < 4; ++i) {
      float a = x[i].x - mean, b = x[i].y - mean, c = x[i].z - mean, d = x[i].w - mean;
      q += a * a + b * b + c * c + d * d;
    }
    float rstd = rsqrtf(wave_sum(q) * (1.f / 1024.f) + 1e-6f);
#pragma unroll
    for (int i = 0; i < 4; ++i) {
      int col = 4 * lane + 256 * i;
      float4 g = *(const float4*)(lg + col);
      float4 b = *(const float4*)(lb + col);
      x[i].x = (x[i].x - mean) * rstd * g.x + b.x;
      x[i].y = (x[i].y - mean) * rstd * g.y + b.y;
      x[i].z = (x[i].z - mean) * rstd * g.z + b.z;
      x[i].w = (x[i].w - mean) * rstd * g.w + b.w;
      if (row < R_LAT) *(float4*)(src + col) = x[i];
    }
    if (l == 0) {
      int v = row < R_LAT ? (row >> 13) : 2;
      ln_modulate_store(x, mod + (size_t)v * 3072, U + (size_t)row * 1024, lane);
    }
  }
}

DI float2 rope16f(float x1, float x2, float pos, int i, float div) {
  float inv = __builtin_amdgcn_exp2f(-(float)i * (13.287712379549449f / div));
  float ang = pos * inv;
  float c = __cosf(ang), s = __sinf(ang);
  return make_float2(x1 * c - x2 * s, x1 * s + x2 * c);
}
#define rope16(X1, X2, POS, I, DIV) do { float2 _rr = rope16f((X1), (X2), (POS), (I), (DIV)); (X1) = _rr.x; (X2) = _rr.y; } while (0)

DI void phase_gemm1(const P& p, int l, unsigned char* smem) {
  const bf16_t* U = (const bf16_t*)(p.ws + OFF_U);
  const bf16_t* Win = (const bf16_t*)(p.ws + OFF_W + WOFF_IN);
  bf16_t* HY = (bf16_t*)(p.ws + OFF_HY);
  bf16_t* GT = (bf16_t*)(p.ws + OFF_GATE);
  bf16_t* CQ = (bf16_t*)(p.ws + OFF_CQ);
  bf16_t* CKV = (bf16_t*)(p.ws + OFF_CKV);
  bf16_t* KR = (bf16_t*)(p.ws + OFF_KR);
  bf16_t* SQ = (bf16_t*)(p.ws + OFF_SQ);
  bf16_t* SK = (bf16_t*)(p.ws + OFF_SK);
  bf16_t* SVT = (bf16_t*)(p.ws + OFF_SVT);
  const int lane = tidx() & 63, wave = tidx() >> 6;
  const int r = lane & 31, h = lane >> 5, wn = wave & 1, wm = wave >> 1;
  const int NMT = R_ALL / 128, NNT = N1 / 128;
  for (int k = 0; k * (int)gridDim.x < NMT * NNT; ++k) {
    int item = xcd_item(k);
    if (item >= NMT * NNT) continue;
    int ntile, mtile;
    if (item < 4 * NMT * 8) { int pnl = item / (NMT * 8), rem = item % (NMT * 8); mtile = rem >> 3; ntile = pnl * 8 + (rem & 7); }
    else { int rem = item - 4 * NMT * 8; mtile = rem >> 1; ntile = 32 + (rem & 1); }
    f32x16 acc[2][2];
    zero_acc(acc);
    gemm_core<true>(Win + (size_t)ntile * 128 * 1024, 1024, U + (size_t)mtile * 128 * 1024, 1024, 1024, acc, smem);
    if (ntile < 27) {
      bf16_t* T = (bf16_t*)smem;
      const bool act = (ntile >= 12 && ntile < 24);
#pragma unroll
      for (int mt = 0; mt < 2; ++mt)
#pragma unroll
        for (int nt = 0; nt < 2; ++nt) {
          f32x16& a = acc[nt][mt];
          bf16_t* tp = T + (wm * 64 + mt * 32 + r) * 136 + wn * 64 + nt * 32 + 4 * h;
#pragma unroll
          for (int g = 0; g < 4; ++g) {
            float v0 = a[4 * g], v1 = a[4 * g + 1], v2 = a[4 * g + 2], v3 = a[4 * g + 3];
            if (act) { v0 = silu_f(v0); v1 = silu_f(v1); v2 = silu_f(v2); v3 = silu_f(v3); }
            uint2 o = {pk2(v0, v1), pk2(v2, v3)};
            *(uint2*)(tp + 8 * g) = o;
          }
        }
      __syncthreads();
      bf16_t* dbase;
      int ld;
      if (ntile < 12) { dbase = HY + ntile * 128; ld = 1536; }
      else if (ntile < 24) { dbase = GT + (ntile - 12) * 128; ld = 1536; }
      else if (ntile < 26) { dbase = CQ + (ntile - 24) * 128; ld = 256; }
      else { dbase = CKV; ld = 128; }
      const int tq = tidx();
#pragma unroll
      for (int i = 0; i < 8; ++i) {
        int q = tq + 256 * i;
        int row = q >> 4, c16 = q & 15;
        uint4 v = *(const uint4*)(T + row * 136 + c16 * 8);
        *(uint4*)(dbase + (size_t)(mtile * 128 + row) * ld + c16 * 8) = v;
      }
      continue;
    }
#pragma unroll
    for (int mt = 0; mt < 2; ++mt) {
      int m = mtile * 128 + wm * 64 + mt * 32 + r;
      RowInfo ri = row_info(m);
#pragma unroll
      for (int nt = 0; nt < 2; ++nt) {
        int nl = wn * 64 + nt * 32 + 4 * h;
        f32x16& a = acc[nt][mt];
        if (ntile < 12) {
#pragma unroll
          for (int g = 0; g < 4; ++g) {
            uint2 o = {pk2(a[4 * g], a[4 * g + 1]), pk2(a[4 * g + 2], a[4 * g + 3])};
            *(uint2*)(HY + (size_t)m * 1536 + ntile * 128 + nl + 8 * g) = o;
          }
        } else if (ntile < 24) {
#pragma unroll
          for (int g = 0; g < 4; ++g) {
            uint2 o = {pk2(silu_f(a[4 * g]), silu_f(a[4 * g + 1])), pk2(silu_f(a[4 * g + 2]), silu_f(a[4 * g + 3]))};
            *(uint2*)(GT + (size_t)m * 1536 + (ntile - 12) * 128 + nl + 8 * g) = o;
          }
        } else if (ntile < 26) {
#pragma unroll
          for (int g = 0; g < 4; ++g) {
            uint2 o = {pk2(a[4 * g], a[4 * g + 1]), pk2(a[4 * g + 2], a[4 * g + 3])};
            *(uint2*)(CQ + (size_t)m * 256 + (ntile - 24) * 128 + nl + 8 * g) = o;
          }
        } else if (ntile == 26) {
#pragma unroll
          for (int g = 0; g < 4; ++g) {
            uint2 o = {pk2(a[4 * g], a[4 * g + 1]), pk2(a[4 * g + 2], a[4 * g + 3])};
            *(uint2*)(CKV + (size_t)m * 128 + nl + 8 * g) = o;
          }
        } else if (ntile < 32) {
          float pos = ri.isctx ? 0.f : (nt == 0 ? (float)ri.prow : (float)ri.pcol);
#pragma unroll
          for (int g = 0; g < 2; ++g)
#pragma unroll
            for (int e = 0; e < 4; ++e) rope16(a[4 * g + e], a[4 * (g + 2) + e], pos, 8 * g + 4 * h + e, 16.f);
          const float sc = (ntile < 31) ? 0.125f * 1.4426950408889634f : 1.f;
          bf16_t* dst = (ntile < 31) ? SQ + (size_t)m * 512 + (ntile - 27) * 128 + nl : SK + (size_t)m * 128 + nl;
#pragma unroll
          for (int g = 0; g < 4; ++g) {
            uint2 o = {pk2(a[4 * g] * sc, a[4 * g + 1] * sc), pk2(a[4 * g + 2] * sc, a[4 * g + 3] * sc)};
            *(uint2*)(dst + 8 * g) = o;
          }
        } else if (ntile == 32) {
#pragma unroll
          for (int g = 0; g < 4; ++g)
#pragma unroll
            for (int e = 0; e < 4; ++e) {
              int d = nt * 32 + 8 * g + 4 * h + e;
              SVT[((size_t)(ri.b * 2 + wn) * 64 + d) * NKEY + ri.kidx] = f2bf(a[4 * g + e]);
            }
        } else {
          if (wn == 0 && nt == 0) {
#pragma unroll
            for (int g = 0; g < 4; g += 2) {
              float pos = ri.isctx ? 0.f : (g == 0 ? (float)ri.prow : (float)ri.pcol);
#pragma unroll
              for (int e = 0; e < 4; ++e) rope16(a[4 * g + e], a[4 * (g + 1) + e], pos, 4 * h + e, 8.f);
            }
#pragma unroll
            for (int g = 0; g < 4; ++g) {
              uint2 o = {pk2(a[4 * g], a[4 * g + 1]), pk2(a[4 * g + 2], a[4 * g + 3])};
              *(uint2*)(KR + (size_t)m * 32 + 4 * h + 8 * g) = o;
            }
          }
        }
      }
    }
  }
  if (l == 0) {
    bf16_t* SGC = (bf16_t*)(p.ws + OFF_SGC);
    const int nb = gridDim.x, b = blockIdx.x;
    const int total = NMT * NNT, full = total / nb, remn = total - full * nb;
    const int myidx = (b & 7) * (nb >> 3) + (b >> 3);
    int first, step;
    if (remn > 0 && nb - remn >= 96) { first = (myidx >= remn) ? myidx - remn : 1 << 30; step = 1 << 30; }
    else { first = b; step = nb; }
    for (int e = first; e < 96; e += step) {
      int mtile = 128 + e / 24, nt24 = e % 24;
      f32x16 acc[2][2];
      zero_acc(acc);
      gemm_core<true>(Win + (size_t)(N1 + nt24 * 128) * 1024, 1024, U + (size_t)mtile * 128 * 1024, 1024, 1024, acc, smem);
#pragma unroll
      for (int mt = 0; mt < 2; ++mt) {
        int m = mtile * 128 + wm * 64 + mt * 32 + r - R_LAT;
#pragma unroll
        for (int nt = 0; nt < 2; ++nt) {
          int nl = wn * 64 + nt * 32 + 4 * h;
          f32x16& a = acc[nt][mt];
#pragma unroll
          for (int g = 0; g < 4; ++g) {
            uint2 o = {pk2(sigm_f(a[4 * g]), sigm_f(a[4 * g + 1])), pk2(sigm_f(a[4 * g + 2]), sigm_f(a[4 * g + 3]))};
            *(uint2*)(SGC + (size_t)m * 3072 + nt24 * 128 + nl + 8 * g) = o;
          }
        }
      }
    }
  }
}

DI void phase_hyprep(const P& p, int l, unsigned char* smem) {
  const bf16_t* __restrict__ HY = (const bf16_t*)(p.ws + OFF_HY);
  bf16_t* GT = (bf16_t*)(p.ws + OFF_GATE);
  bf16_t* UT = (bf16_t*)(p.ws + OFF_UT);
  float* UC = (float*)(p.ws + OFF_UC);
  bf16_t* tile = (bf16_t*)smem;
  const float* cw = p.hy_conv_w + (size_t)l * 3 * 1536;
  const float* cb = p.hy_conv_b + (size_t)l * 1536;
  const int t = tidx();
  const int c = 2 * t;
  const int nitems = (l == 0) ? R_ALL / 32 : R_LAT / 32;
  float w0[3][2], w1[3][2], w2[3][2], bb[3][2];
#pragma unroll
  for (int s3 = 0; s3 < 3; ++s3)
#pragma unroll
    for (int e = 0; e < 2; ++e) {
      w0[s3][e] = cw[0 * 1536 + s3 * 512 + c + e];
      w1[s3][e] = cw[1 * 1536 + s3 * 512 + c + e];
      w2[s3][e] = cw[2 * 1536 + s3 * 512 + c + e];
      bb[s3][e] = cb[s3 * 512 + c + e];
    }
  for (int item = blockIdx.x; item < nitems; item += gridDim.x) {
    int r0 = item * 32;
    bool isctx = r0 >= R_LAT;
    int seqlen = isctx ? LC : S_LAT;
    int t0 = isctx ? ((r0 - R_LAT) & (LC - 1)) : (r0 & (S_LAT - 1));
    int b = isctx ? ((r0 - R_LAT) >> 8) : (r0 >> 13);
    unsigned pv[3], cv[3];
#pragma unroll
    for (int s3 = 0; s3 < 3; ++s3) {
      pv[s3] = (t0 > 0) ? *(const unsigned*)(HY + (size_t)(r0 - 1) * 1536 + s3 * 512 + c) : 0u;
      cv[s3] = *(const unsigned*)(HY + (size_t)r0 * 1536 + s3 * 512 + c);
    }
    __syncthreads();
    for (int i0 = 0; i0 < 32; i0 += 16) {
      unsigned nv[16][3], gg[16];
#pragma unroll
      for (int ii = 0; ii < 16; ++ii) {
        int i = i0 + ii;
        bool hasn = (t0 + i + 1) < seqlen;
#pragma unroll
        for (int s3 = 0; s3 < 3; ++s3) nv[ii][s3] = hasn ? *(const unsigned*)(HY + (size_t)(r0 + i + 1) * 1536 + s3 * 512 + c) : 0u;
        gg[ii] = *(const unsigned*)(GT + (size_t)(r0 + i) * 1536 + c);
      }
#pragma unroll
      for (int ii = 0; ii < 16; ++ii) {
        int i = i0 + ii;
        int row = r0 + i;
        float z[3][2];
#pragma unroll
        for (int s3 = 0; s3 < 3; ++s3) {
          z[s3][0] = bb[s3][0] + w0[s3][0] * bflo(pv[s3]) + w1[s3][0] * bflo(cv[s3]) + w2[s3][0] * bflo(nv[ii][s3]);
          z[s3][1] = bb[s3][1] + w0[s3][1] * bfhi(pv[s3]) + w1[s3][1] * bfhi(cv[s3]) + w2[s3][1] * bfhi(nv[ii][s3]);
        }
        float uh0 = z[2][0] * z[1][0], uh1 = z[2][1] * z[1][1];
        *(unsigned*)(GT + (size_t)row * 1536 + c) = pk2(bflo(gg[ii]) * z[0][0], bfhi(gg[ii]) * z[0][1]);
        if (isctx) { *(float2*)(UC + (size_t)(row - R_LAT) * 512 + c) = make_float2(uh0, uh1); }
        else { tile[c * 34 + i] = f2bf(uh0); tile[(c + 1) * 34 + i] = f2bf(uh1); }
#pragma unroll
        for (int s3 = 0; s3 < 3; ++s3) { pv[s3] = cv[s3]; cv[s3] = nv[ii][s3]; }
      }
    }
    __syncthreads();
    if (!isctx) {
      for (int idx = t; idx < 512 * 16; idx += 256) {
        int cl = idx >> 4, pr = idx & 15;
        unsigned v = *(const unsigned*)(tile + cl * 34 + 2 * pr);
        *(unsigned*)(UT + (size_t)cl * 16384 + b * 8192 + t0 + 2 * pr) = v;
      }
    }
  }
}

DI void row_rms(const bf16_t* __restrict__ src, int ld, int ncol, float* rs  ) {
  const int t = tidx();
  int row = t >> 1, hf = t & 1;
  int per = ncol >> 1;
  const bf16_t* q = src + (size_t)row * ld + hf * per;
  float s = 0.f;
  for (int i = 0; i < per; i += 8) {
    uint4 v = *(const uint4*)(q + i);
    float a;
    a = bflo(v.x); s += a * a; a = bfhi(v.x); s += a * a;
    a = bflo(v.y); s += a * a; a = bfhi(v.y); s += a * a;
    a = bflo(v.z); s += a * a; a = bfhi(v.z); s += a * a;
    a = bflo(v.w); s += a * a; a = bfhi(v.w); s += a * a;
  }
  s += __shfl_xor(s, 1);
  if (hf == 0) rs[row] = rsqrtf(s / (float)ncol + 1e-6f);
}

DI void phase_upproj(const P& p, int l, unsigned char* smem, float* rs) {
  const bf16_t* CQ = (const bf16_t*)(p.ws + OFF_CQ);
  const bf16_t* CKV = (const bf16_t*)(p.ws + OFF_CKV);
  const bf16_t* Wuq = (const bf16_t*)(p.ws + OFF_W + WOFF_UQ);
  const bf16_t* Wukv = (const bf16_t*)(p.ws + OFF_W + WOFF_UKV);
  bf16_t* QN = (bf16_t*)(p.ws + OFF_QN);
  bf16_t* QR = (bf16_t*)(p.ws + OFF_QR);
  bf16_t* KN = (bf16_t*)(p.ws + OFF_KN);
  bf16_t* VTM = (bf16_t*)(p.ws + OFF_VTM);
  const int lane = tidx() & 63, wave = tidx() >> 6;
  const int r = lane & 31, h = lane >> 5, wn = wave & 1, wm = wave >> 1;
  const int NMT = R_ALL / 128;
  const int n_kv = NMT * 8;
  const int nmq = (l == 0) ? NMT : R_LAT / 128;
  const int n_q = nmq * 6;
  const float qscale = 0.10206207261596577f * 1.4426950408889634f;
  for (int item = blockIdx.x; item < n_kv + n_q; item += gridDim.x) {
    bool iskv = item < n_kv;
    int mtile, ntile;
    if (iskv) { mtile = item % NMT; ntile = item / NMT; }
    else { int it = item - n_kv; mtile = it % nmq; ntile = it / nmq; }
    f32x16 acc[2][2];
    zero_acc(acc);
    __syncthreads();
    if (iskv) row_rms(CKV + (size_t)mtile * 128 * 128, 128, 128, rs);
    else row_rms(CQ + (size_t)mtile * 128 * 256, 256, 256, rs);
    if (iskv) gemm_core(Wukv + (size_t)ntile * 128 * 128, 128, CKV + (size_t)mtile * 128 * 128, 128, 128, acc, smem);
    else gemm_core(Wuq + (size_t)ntile * 128 * 256, 256, CQ + (size_t)mtile * 128 * 256, 256, 256, acc, smem);
#pragma unroll
    for (int mt = 0; mt < 2; ++mt) {
      int ml = wm * 64 + mt * 32 + r;
      int m = mtile * 128 + ml;
      RowInfo ri = row_info(m);
      float rsv = rs[ml];
#pragma unroll
      for (int nt = 0; nt < 2; ++nt) {
        f32x16& a = acc[nt][mt];
        int nl = wn * 64 + nt * 32 + 4 * h;
        if (iskv) {
          if (wn == 0) {
#pragma unroll
            for (int g = 0; g < 4; ++g) {
              uint2 o = {pk2(a[4 * g] * rsv, a[4 * g + 1] * rsv), pk2(a[4 * g + 2] * rsv, a[4 * g + 3] * rsv)};
              *(uint2*)(KN + (size_t)m * 512 + ntile * 64 + nt * 32 + 4 * h + 8 * g) = o;
            }
          } else {
#pragma unroll
            for (int g = 0; g < 4; ++g)
#pragma unroll
              for (int e = 0; e < 4; ++e) {
                int d = nt * 32 + 8 * g + 4 * h + e;
                VTM[((size_t)(ri.b * 8 + ntile) * 64 + d) * NKEY + ri.kidx] = f2bf(a[4 * g + e] * rsv);
              }
          }
        } else {
          float sc = rsv * qscale;
          if (ntile < 4) {
#pragma unroll
            for (int g = 0; g < 4; ++g) {
              uint2 o = {pk2(a[4 * g] * sc, a[4 * g + 1] * sc), pk2(a[4 * g + 2] * sc, a[4 * g + 3] * sc)};
              *(uint2*)(QN + (size_t)m * 512 + ntile * 128 + nl + 8 * g) = o;
            }
          } else {
#pragma unroll
            for (int g = 0; g < 4; g += 2) {
              float pos = ri.isctx ? 0.f : (g == 0 ? (float)ri.prow : (float)ri.pcol);
#pragma unroll
              for (int e = 0; e < 4; ++e) rope16(a[4 * g + e], a[4 * (g + 1) + e], pos, 4 * h + e, 8.f);
            }
#pragma unroll
            for (int g = 0; g < 4; ++g) {
              uint2 o = {pk2(a[4 * g] * sc, a[4 * g + 1] * sc), pk2(a[4 * g + 2] * sc, a[4 * g + 3] * sc)};
              *(uint2*)(QR + (size_t)m * 256 + (ntile - 4) * 128 + nl + 8 * g) = o;
            }
          }
        }
      }
    }
  }
}

constexpr int KROW = 208;
constexpr int VROW = 136;
constexpr int ATT_BUF = 64 * KROW + 64 * VROW;

template <int DQK>
DI void attn_load(const bf16_t* __restrict__ ka, int lda, const bf16_t* __restrict__ kb, const bf16_t* __restrict__ vt,
                  int krow0, int kcol0, uint4& g0, uint4& g1, uint4& g2, uint4& g3, uint4& g4) {
  const int t = tidx();
  {
    int key = t >> 3, c = t & 7;
    g0 = *(const uint4*)(ka + (size_t)(krow0 + key) * lda + c * 8);
    g1 = *(const uint4*)(ka + (size_t)(krow0 + 32 + key) * lda + c * 8);
    g2 = *(const uint4*)(vt + (size_t)key * NKEY + kcol0 + c * 8);
    g3 = *(const uint4*)(vt + (size_t)(32 + key) * NKEY + kcol0 + c * 8);
  }
  if constexpr (DQK == 96) {
    int key = t >> 2, c = t & 3;
    g4 = *(const uint4*)(kb + (size_t)(krow0 + key) * 32 + c * 8);
  }
}
template <int DQK>
DI void attn_store(unsigned char* buf, const uint4& g0, const uint4& g1, const uint4& g2, const uint4& g3, const uint4& g4) {
  const int t = tidx();
  {
    int key = t >> 3, c = t & 7;
    *(uint4*)(buf + key * KROW + c * 16) = g0;
    *(uint4*)(buf + (32 + key) * KROW + c * 16) = g1;
    unsigned char* q = buf + 64 * KROW + key * VROW + c * 16;
    *(uint2*)(q) = make_uint2(g2.x, g2.y);
    *(uint2*)(q + 8) = make_uint2(g2.z, g2.w);
    q += 32 * VROW;
    *(uint2*)(q) = make_uint2(g3.x, g3.y);
    *(uint2*)(q + 8) = make_uint2(g3.z, g3.w);
  }
  if constexpr (DQK == 96) {
    int key = t >> 2, c = t & 3;
    *(uint4*)(buf + key * KROW + 128 + c * 16) = g4;
  }
}

template <bool MASK>
DI void attn_half(f32x16& s, f32x16& sother, int T, const unsigned char* vb, bool domask, int kpc, int qpos, f32x16& negm,
                  float& lsum, f32x16 (&o)[2], int h, bool first) {
  if (MASK && domask) {
#pragma unroll
    for (int i = 0; i < 16; ++i) {
      int kk = kpc + 32 * T + (i & 3) + 8 * (i >> 2) + 4 * h;
      int d0 = qpos - kk;
      if (d0 > 128 || d0 < -128) s[i] = -1e30f;
    }
  }
  float mx = fmaxf(fmaxf(s[0], s[1]), s[2]);
#pragma unroll
  for (int i = 3; i < 15; i += 2) mx = fmaxf(fmaxf(mx, s[i]), s[i + 1]);
  mx = fmaxf(mx, s[15]);
  if (first || __builtin_amdgcn_ballot_w64(mx > 8.f) != 0ull) {
    mx = fmaxf(mx, __shfl_xor(mx, 32));
    float d = first ? mx : fmaxf(mx, 0.f);
    float alpha = first ? 1.f : __builtin_amdgcn_exp2f(-d);
    lsum *= alpha;
#pragma unroll
    for (int i = 0; i < 16; ++i) { o[0][i] *= alpha; o[1][i] *= alpha; s[i] -= d; negm[i] -= d; }
    if (T == 0) {
#pragma unroll
      for (int i = 0; i < 16; ++i) sother[i] -= d;
    }
  }
#pragma unroll
  for (int i = 0; i < 16; ++i) {
    s[i] = __builtin_amdgcn_exp2f(s[i]);
    lsum += s[i];
  }
#pragma unroll
  for (int st = 0; st < 2; ++st) {
    bf16x8 pb = MKFRAG(pk2(s[8 * st + 0], s[8 * st + 1]), pk2(s[8 * st + 2], s[8 * st + 3]),
                       pk2(s[8 * st + 4], s[8 * st + 5]), pk2(s[8 * st + 6], s[8 * st + 7]));
#pragma unroll
    for (int mt = 0; mt < 2; ++mt) {
      const unsigned char* vp = vb + (32 * mt) * VROW + (32 * T + 16 * st) * 2;
      uint2 lo = *(const uint2*)(vp);
      uint2 hi = *(const uint2*)(vp + 16);
      bf16x8 av = MKFRAG(lo.x, lo.y, hi.x, hi.y);
      o[mt] = MFMA(av, pb, o[mt]);
    }
  }
}

template <int DQK, bool MASK>
DI void attn_compute(const unsigned char* cur, const bf16x8 (&qf)[DQK / 16], bool domask, int kpc, int qpos, f32x16& negm,
                     float& lsum, f32x16 (&o)[2], int r, int h, bool first) {
  f32x16 s0 = negm, s1 = negm;
  __builtin_amdgcn_s_setprio(1);
#pragma unroll
  for (int ks = 0; ks < DQK / 16; ++ks) {
    bf16x8 a0 = *(const bf16x8*)(cur + r * KROW + (2 * ks + h) * 16);
    s0 = MFMA(a0, qf[ks], s0);
  }
#pragma unroll
  for (int ks = 0; ks < DQK / 16; ++ks) {
    bf16x8 a1 = *(const bf16x8*)(cur + (32 + r) * KROW + (2 * ks + h) * 16);
    s1 = MFMA(a1, qf[ks], s1);
  }
  __builtin_amdgcn_s_setprio(0);
  const unsigned char* vb = cur + 64 * KROW + r * VROW + 8 * h;
  attn_half<MASK>(s0, s1, 0, vb, domask, kpc, qpos, negm, lsum, o, h, first);
  attn_half<MASK>(s1, s0, 1, vb, domask, kpc, qpos, negm, lsum, o, h, false);
}

#define A_LOAD(S, IT)                                                                                     \
  {                                                                                                       \
    int itn_ = (IT);                                                                                      \
    int kp_ = wlo + (itn_ - 4) * 64;                                                                      \
    int krow0_ = (itn_ < 4) ? ctxrow0 + itn_ * 64 : latrow0 + kp_;                                        \
    int kcol0_ = (itn_ < 4) ? itn_ * 64 : LC + kp_;                                                       \
    attn_load<DQK>(ka, lda, kb, vt, krow0_, kcol0_, S##0, S##1, S##2, S##3, S##4);                        \
  }
template <int DQK, bool MASK>
DI void attn_block(const bf16_t* __restrict__ ka, int lda, const bf16_t* __restrict__ kb, const bf16_t* __restrict__ vt,
                   const bf16x8 (&qf)[DQK / 16], int ntiles, int ctxrow0, int latrow0, int wlo, int qpos,
                   float m_init, float l_init, f32x16 (&o)[2], float& l_out, unsigned char* smem) {
  const int lane = tidx() & 63;
  const int r = lane & 31, h = lane >> 5;
  uint4 ga0, ga1, ga2, ga3, ga4, gb0, gb1, gb2, gb3, gb4;
  const bool nofs = m_init < -1e29f;
  float lsum = l_init;
  f32x16 negm;
#pragma unroll
  for (int i = 0; i < 16; ++i) { o[0][i] = 0.f; o[1][i] = 0.f; negm[i] = nofs ? 0.f : -m_init; }
  A_LOAD(ga, 0);
  A_LOAD(gb, 1);
  __syncthreads();
  attn_store<DQK>(smem, ga0, ga1, ga2, ga3, ga4);
  if (ntiles > 2) A_LOAD(ga, 2);
  __syncthreads();
  for (int it = 0; it < ntiles; it += 2) {
    attn_compute<DQK, MASK>(smem, qf, it >= 4, wlo + (it - 4) * 64, qpos, negm, lsum, o, r, h, nofs && it == 0);
    attn_store<DQK>(smem + ATT_BUF, gb0, gb1, gb2, gb3, gb4);
    if (it + 3 < ntiles) A_LOAD(gb, it + 3);
    __syncthreads();
    attn_compute<DQK, MASK>(smem + ATT_BUF, qf, it + 1 >= 4, wlo + (it - 3) * 64, qpos, negm, lsum, o, r, h, false);
    if (it + 2 < ntiles) {
      attn_store<DQK>(smem, ga0, ga1, ga2, ga3, ga4);
      if (it + 4 < ntiles) A_LOAD(ga, it + 4);
    }
    __syncthreads();
  }
  l_out = lsum + __shfl_xor(lsum, 32);
}

DI void attn_finish(f32x16 (&o)[2], float l, bf16_t* grow  ) {
  const int lane = tidx() & 63;
  const int h = lane >> 5;
  float inv = 1.f / l;
  uint2 gv[2][4];
#pragma unroll
  for (int mt = 0; mt < 2; ++mt)
#pragma unroll
    for (int g = 0; g < 4; ++g) gv[mt][g] = *(const uint2*)(grow + 32 * mt + 8 * g + 4 * h);
#pragma unroll
  for (int mt = 0; mt < 2; ++mt)
#pragma unroll
    for (int g = 0; g < 4; ++g) {
      float y0 = o[mt][4 * g] * inv * bflo(gv[mt][g].x);
      float y1 = o[mt][4 * g + 1] * inv * bfhi(gv[mt][g].x);
      float y2 = o[mt][4 * g + 2] * inv * bflo(gv[mt][g].y);
      float y3 = o[mt][4 * g + 3] * inv * bfhi(gv[mt][g].y);
      uint2 ov = {pk2(y0, y1), pk2(y2, y3)};
      *(uint2*)(grow + 32 * mt + 8 * g + 4 * h) = ov;
    }
}

DI void mla_item(const P& p, int b, int hh, int qb, bool ctxq, unsigned char* smem, bool dry = false) {
  const bf16_t* QN = (const bf16_t*)(p.ws + OFF_QN);
  const bf16_t* QR = (const bf16_t*)(p.ws + OFF_QR);
  bf16_t* GT = (bf16_t*)(p.ws + OFF_GATE);
  const int lane = tidx() & 63, wave = tidx() >> 6;
  const int r = lane & 31, h = lane >> 5;
  const bf16_t* ka = (const bf16_t*)(p.ws + OFF_KN) + hh * 64;
  const bf16_t* kb = (const bf16_t*)(p.ws + OFF_KR);
  const bf16_t* vt = (const bf16_t*)(p.ws + OFF_VTM) + (size_t)(b * 8 + hh) * 64 * NKEY;
  int qrow = (ctxq ? R_LAT + b * LC : b * S_LAT) + qb * 128 + wave * 32 + r;
  bf16x8 qf[6];
#pragma unroll
  for (int ks = 0; ks < 4; ++ks) qf[ks] = *(const bf16x8*)(QN + (size_t)qrow * 512 + hh * 64 + ks * 16 + 8 * h);
#pragma unroll
  for (int ks = 0; ks < 2; ++ks) qf[4 + ks] = *(const bf16x8*)(QR + (size_t)qrow * 256 + hh * 32 + ks * 16 + 8 * h);
  const int ctxrow0 = R_LAT + b * LC, latrow0 = b * S_LAT;
  f32x16 o[2];
  float l;
  attn_block<96, false>(ka, 512, kb, vt, qf, ctxq ? 4 : NKEY / 64, ctxrow0, latrow0, 0, 0, -1e30f, 0.f, o, l, smem);
  if (!dry || p.phase_lo < 0) attn_finish(o, l, GT + (size_t)qrow * 1536 + 512 + hh * 64);
}

DI void swa_item(const P& p, int l_, int b, int hd, int qb, bool ctxq, unsigned char* smem, bool dry = false) {
  const bf16_t* SQ = (const bf16_t*)(p.ws + OFF_SQ);
  bf16_t* GT = (bf16_t*)(p.ws + OFF_GATE);
  const int lane = tidx() & 63, wave = tidx() >> 6;
  const int r = lane & 31, h = lane >> 5;
  const int g = hd >> 2;
  const bf16_t* ka = (const bf16_t*)(p.ws + OFF_SK) + g * 64;
  const bf16_t* vt = (const bf16_t*)(p.ws + OFF_SVT) + (size_t)(b * 2 + g) * 64 * NKEY;
  int qpos = qb * 128 + wave * 32 + r;
  int qrow = (ctxq ? R_LAT + b * LC : b * S_LAT) + qpos;
  bf16x8 qf[4];
#pragma unroll
  for (int ks = 0; ks < 4; ++ks) qf[ks] = *(const bf16x8*)(SQ + (size_t)qrow * 512 + hd * 64 + ks * 16 + 8 * h);
  const int ctxrow0 = R_LAT + b * LC, latrow0 = b * S_LAT;
  int wlo = (qb - 1) * 128; if (wlo < 0) wlo = 0;
  int whi = (qb + 2) * 128; if (whi > S_LAT) whi = S_LAT;
  int nt = ctxq ? 4 : 4 + (whi - wlo) / 64;
  float sk = p.sink[l_ * 8 + hd] * 1.4426950408889634f;
  f32x16 o[2];
  float l;
  attn_block<64, true>(ka, 128, nullptr, vt, qf, nt, ctxrow0, latrow0, wlo, qpos, sk, (h == 0) ? 1.f : 0.f, o, l, smem);
  if (!dry || p.phase_lo < 0) attn_finish(o, l, GT + (size_t)qrow * 1536 + 1024 + hd * 64);
}

DI void hyena_item(const P& p, int c, unsigned char* smem, bool dry = false) {
  const bf16_t* Fg = (const bf16_t*)(p.ws + OFF_FG) + (size_t)c * 16384;
  const bf16_t* UT = (const bf16_t*)(p.ws + OFF_UT) + (size_t)c * 16384;
  bf16_t* GT = (bf16_t*)(p.ws + OFF_GATE);
  const int t = tidx();
  const int lane = t & 63, wave = t >> 6;
  const int r = lane & 31, h = lane >> 5;
  const unsigned* F32 = (const unsigned*)smem;
  unsigned char* Ub = smem + 32768;
  __syncthreads();
#pragma unroll
  for (int i = 0; i < 8; ++i) {
    int idx = t + 256 * i;
    *(uint4*)(smem + idx * 16) = *(const uint4*)(Fg + idx * 8);
    int bb = idx >> 10, j = (idx >> 3) & 127, ch = idx & 7;
    uint4 v = *(const uint4*)(UT + idx * 8);
    *(uint4*)(Ub + bb * 16512 + j * 128 + ((ch ^ ((j >> 1) & 7)) << 4)) = v;
  }
  if (t < 16) *(uint4*)(Ub + (t >> 3) * 16512 + 128 * 128 + (t & 7) * 16) = make_uint4(0u, 0u, 0u, 0u);
  __syncthreads();
  const int ibase = 32 * wave;
  f32x16 acc[2][2];
  zero_acc(acc);
#define HY_FRAG(DST, Q)                                                                              \
  {                                                                                                  \
    int z0_ = 8192 - 16 * (Q) - r + 8 * h;                                                           \
    int dw_ = z0_ >> 1;                                                                              \
    unsigned x0_ = F32[dw_], x1_ = F32[dw_ + 1], x2_ = F32[dw_ + 2], x3_ = F32[dw_ + 3], x4_ = F32[dw_ + 4]; \
    DST = MKFRAG(__builtin_amdgcn_alignbit(x1_, x0_, sh), __builtin_amdgcn_alignbit(x2_, x1_, sh),    \
                 __builtin_amdgcn_alignbit(x3_, x2_, sh), __builtin_amdgcn_alignbit(x4_, x3_, sh));   \
  }
  const unsigned sh = (unsigned)((r & 1) * 16);
  bf16x8 f0, f1, f2, f3, f4, f5;
  {
    const int d0 = ibase - 127;
    HY_FRAG(f4, 4 * d0 - 3);
    HY_FRAG(f5, 4 * d0 - 2);
  }
#pragma unroll 1
  for (int d = ibase - 127; d <= ibase + 31; ++d) {
    f0 = f4; f1 = f5;
    HY_FRAG(f2, 4 * d - 1);
    HY_FRAG(f3, 4 * d);
    HY_FRAG(f4, 4 * d + 1);
    HY_FRAG(f5, 4 * d + 2);
    int j = ibase - d + r;
    int jc = ((unsigned)j < 128u) ? j : 128;
    const unsigned char* ub = Ub + jc * 128;
    const int sw = (jc >> 1) & 7;
#pragma unroll
    for (int bt = 0; bt < 2; ++bt) {
      const unsigned char* ubb = ub + bt * 16512;
      bf16x8 b0 = *(const bf16x8*)(ubb + (((0 + h) ^ sw) << 4));
      bf16x8 b1 = *(const bf16x8*)(ubb + (((2 + h) ^ sw) << 4));
      bf16x8 b2 = *(const bf16x8*)(ubb + (((4 + h) ^ sw) << 4));
      bf16x8 b3 = *(const bf16x8*)(ubb + (((6 + h) ^ sw) << 4));
      acc[0][bt] = MFMA(f3, b0, acc[0][bt]); acc[1][bt] = MFMA(f5, b0, acc[1][bt]);
      acc[0][bt] = MFMA(f2, b1, acc[0][bt]); acc[1][bt] = MFMA(f4, b1, acc[1][bt]);
      acc[0][bt] = MFMA(f1, b2, acc[0][bt]); acc[1][bt] = MFMA(f3, b2, acc[1][bt]);
      acc[0][bt] = MFMA(f0, b3, acc[0][bt]); acc[1][bt] = MFMA(f2, b3, acc[1][bt]);
    }
  }
  if (!dry || p.phase_lo < 0)
#pragma unroll
  for (int mi = 0; mi < 2; ++mi)
#pragma unroll
    for (int bt = 0; bt < 2; ++bt) {
      int i = ibase + r;
      bf16_t gvals[16];
#pragma unroll
      for (int reg = 0; reg < 16; ++reg) {
        int a2 = 32 * mi + (reg & 3) + 8 * (reg >> 2) + 4 * h;
        size_t grow = (size_t)bt * 8192 + 64 * i + a2;
        gvals[reg] = GT[grow * 1536 + c];
      }
#pragma unroll
      for (int reg = 0; reg < 16; ++reg) {
        int a2 = 32 * mi + (reg & 3) + 8 * (reg >> 2) + 4 * h;
        size_t grow = (size_t)bt * 8192 + 64 * i + a2;
        GT[grow * 1536 + c] = f2bf(bf2f(gvals[reg]) * acc[mi][bt][reg]);
      }
    }
}

DI void hyena_ctx_item(const P& p, int item) {
  const float* __restrict__ Fc = (const float*)(p.ws + OFF_FC);
  const float* __restrict__ UC = (const float*)(p.ws + OFF_UC);
  bf16_t* GT = (bf16_t*)(p.ws + OFF_GATE);
  const int t = tidx();
  int r0 = item * 8;
  int b = r0 >> 8, t0 = r0 & 255;
  for (int hc = 0; hc < 2; ++hc) {
    int c = hc * 256 + t;
    float acc[8], win[8];
#pragma unroll
    for (int i = 0; i < 8; ++i) { acc[i] = 0.f; win[i] = Fc[(size_t)(255 + t0 + i) * 512 + c]; }
#pragma unroll 8
    for (int s = 0; s < 256; ++s) {
      float u = UC[(size_t)(b * 256 + s) * 512 + c];
#pragma unroll
      for (int i = 0; i < 8; ++i) acc[i] += win[i] * u;
#pragma unroll
      for (int i = 7; i > 0; --i) win[i] = win[i - 1];
      int nidx = 255 + t0 - s - 1;
      win[0] = (nidx >= 0) ? Fc[(size_t)nidx * 512 + c] : 0.f;
    }
#pragma unroll
    for (int i = 0; i < 8; ++i) {
      bf16_t* q = GT + (size_t)(R_LAT + r0 + i) * 1536 + c;
      *q = f2bf(bf2f(*q) * acc[i]);
    }
  }
}

DI void phase_mixers(const P& p, int l, unsigned char* smem, int* s_item) {
  unsigned* ctr = (unsigned*)(p.ws + OFF_CTR) + l;
  const int n_mla = 1024, n_hy = 512, n_swa = 1024;
  const int n_cm = (l == 0) ? 32 : 0, n_cs = (l == 0) ? 32 : 0, n_ch = (l == 0) ? 64 : 0;
  const int c0 = n_ch, c1 = c0 + n_cm, c2 = c1 + n_cs;
  const int e0 = c2 + n_mla, e1 = e0 + n_hy, e2 = e1 + n_swa;
  for (;;) {
    __syncthreads();
    if (tidx() == 0) *s_item = (int)atomicAdd(ctr, 1u);
    __syncthreads();
    int item = *s_item;
    if (item >= e2) break;
    if (item < c0) {
      hyena_ctx_item(p, item);
    } else if (item < c1) {
      int it = item - c0;
      mla_item(p, it >> 4, (it >> 1) & 7, it & 1, true, smem);
    } else if (item < c2) {
      int it = item - c1;
      swa_item(p, l, it >> 4, (it >> 1) & 7, it & 1, true, smem);
    } else if (item < e0) {
      int it = item - c2;
      mla_item(p, it >> 9, (it >> 6) & 7, it & 63, false, smem);
    } else if (item < e1) {
      hyena_item(p, item - e0, smem);
    } else {
      int it = item - e1;
      swa_item(p, l, it >> 9, (it >> 6) & 7, it & 63, false, smem);
    }
  }
}

DI void phase_mixers_dry(const P& p, int l, unsigned char* smem, int kind) {
  if (kind == 1) {
    for (int item = blockIdx.x; item < 1024; item += gridDim.x) mla_item(p, item >> 9, (item >> 6) & 7, item & 63, false, smem, true);
  } else if (kind == 2) {
    for (int item = blockIdx.x; item < 512; item += gridDim.x) hyena_item(p, item, smem, true);
  } else {
    for (int item = blockIdx.x; item < 1024; item += gridDim.x) swa_item(p, l, item >> 9, (item >> 6) & 7, item & 63, false, smem, true);
  }
}

DI void phase_merge(const P& p, int l, unsigned char* smem) {
  const bf16_t* U = (const bf16_t*)(p.ws + OFF_U);
  const bf16_t* Wmg = (const bf16_t*)(p.ws + OFF_W + WOFF_IN) + (size_t)N1 * 1024;
  const bf16_t* Wp = (const bf16_t*)(p.ws + OFF_W + WOFF_P);
  const bf16_t* Y = (const bf16_t*)(p.ws + OFF_GATE);
  bf16_t* M = (bf16_t*)(p.ws + OFF_M);
  const int lane = tidx() & 63, wave = tidx() >> 6;
  const int r = lane & 31, h = lane >> 5, wn = wave & 1, wm = wave >> 1;
  const int nm = (l == 0) ? R_ALL / 128 : R_LAT / 128;
  const int spx = gridDim.x >> 3;
  const int xcd = blockIdx.x & 7, slot = blockIdx.x >> 3;
  const int pair = xcd & 3, mhalf = xcd >> 2, nmh = (R_LAT / 128) >> 1;
  const bf16_t* SGC = (const bf16_t*)(p.ws + OFF_SGC);
  const int nctx = (l == 0) ? 4 : 0;
  const int nlat = nmh * 2;
  for (int k = 0; k * spx < nlat + nctx + spx - 1; ++k) {
    int j = k * spx + slot;
    int jj = j;
    bool isc = false;
    if (jj >= nlat) {
      int base = ((nlat + spx - 1) / spx) * spx;
      if (j < base || j >= base + nctx) continue;
      jj = j - base;
      isc = true;
    }
    int mtile, ntile;
    if (!isc) { mtile = mhalf * nmh + (jj >> 1); ntile = 2 * pair + (jj & 1); }
    else { mtile = R_LAT / 128 + 2 * mhalf + (jj >> 1); ntile = 2 * pair + (jj & 1); }
    unsigned msum[2][2][8];
#pragma unroll
    for (int i = 0; i < 2; ++i)
#pragma unroll
      for (int j = 0; j < 2; ++j)
#pragma unroll
        for (int k = 0; k < 8; ++k) msum[i][j][k] = 0u;
#pragma unroll 1
    for (int br = 0; br < 3; ++br) {
      f32x16 acc[2][2];
      unsigned sg[2][2][8];
      if (!isc) {
        zero_acc(acc);
        gemm_core(Wmg + (size_t)(br * 1024 + ntile * 128) * 1024, 1024, U + (size_t)mtile * 128 * 1024, 1024, 1024, acc, smem);
#pragma unroll
        for (int i = 0; i < 2; ++i)
#pragma unroll
          for (int j = 0; j < 2; ++j)
#pragma unroll
            for (int k = 0; k < 8; ++k) sg[i][j][k] = pk2(sigm_f(acc[i][j][2 * k]), sigm_f(acc[i][j][2 * k + 1]));
      } else {
#pragma unroll
        for (int i = 0; i < 2; ++i)
#pragma unroll
          for (int j = 0; j < 2; ++j) {
            int mrow = mtile * 128 + wm * 64 + j * 32 + r - R_LAT;
            const bf16_t* gp = SGC + (size_t)mrow * 3072 + br * 1024 + ntile * 128 + wn * 64 + i * 32 + 4 * h;
#pragma unroll
            for (int g = 0; g < 4; ++g) {
              uint2 v = *(const uint2*)(gp + 8 * g);
              sg[i][j][2 * g] = v.x;
              sg[i][j][2 * g + 1] = v.y;
            }
          }
      }
      zero_acc(acc);
      gemm_core(Wp + (size_t)(br * 1024 + ntile * 128) * 512, 512, Y + (size_t)mtile * 128 * 1536 + br * 512, 1536, 512, acc, smem);
#pragma unroll
      for (int i = 0; i < 2; ++i)
#pragma unroll
        for (int j = 0; j < 2; ++j)
#pragma unroll
          for (int k = 0; k < 8; ++k) {
            float lo = bflo(msum[i][j][k]) + bflo(sg[i][j][k]) * acc[i][j][2 * k];
            float hi = bfhi(msum[i][j][k]) + bfhi(sg[i][j][k]) * acc[i][j][2 * k + 1];
            msum[i][j][k] = pk2(lo, hi);
          }
    }
#pragma unroll
    for (int mt = 0; mt < 2; ++mt) {
      int m = mtile * 128 + wm * 64 + mt * 32 + r;
#pragma unroll
      for (int nt = 0; nt < 2; ++nt) {
        int n = ntile * 128 + wn * 64 + nt * 32 + 4 * h;
#pragma unroll
        for (int g = 0; g < 4; ++g) {
          uint2 o = {msum[nt][mt][2 * g], msum[nt][mt][2 * g + 1]};
          *(uint2*)(M + (size_t)m * 1024 + n + 8 * g) = o;
        }
      }
    }
  }
}

DI void phase_out(const P& p, int l, unsigned char* smem) {
  const bf16_t* M = (const bf16_t*)(p.ws + OFF_M);
  const bf16_t* Wo = (const bf16_t*)(p.ws + OFF_W + WOFF_OUT);
  const float* mod = (const float*)(p.ws + OFF_MOD) + (size_t)l * 3 * 3072;
  float* zc = (float*)(p.ws + OFF_ZC);
  const int lane = tidx() & 63, wave = tidx() >> 6;
  const int r = lane & 31, h = lane >> 5, wn = wave & 1, wm = wave >> 1;
  const int nm = (l == 0) ? R_ALL / 128 : R_LAT / 128;
  const float ALPHA = 1.4142135623730951f;
  for (int k = 0; k * (int)gridDim.x < nm * 8; ++k) {
    int item = xcd_item(k);
    if (item >= nm * 8) continue;
    int mtile = item >> 3, ntile = item & 7;
    f32x16 acc[2][2];
    zero_acc(acc);
    gemm_core<true>(Wo + (size_t)ntile * 128 * 1024, 1024, M + (size_t)mtile * 128 * 1024, 1024, 1024, acc, smem);
#pragma unroll
    for (int mt = 0; mt < 2; ++mt) {
      int m = mtile * 128 + wm * 64 + mt * 32 + r;
      const float* xin;
      float* dst;
      int v;
      if (m < R_LAT) {
        xin = (l == 0 ? p.x : p.out) + (size_t)m * 1024;
        dst = p.out + (size_t)m * 1024;
        v = m >> 13;
      } else {
        xin = p.ctx + (size_t)(m - R_LAT) * 1024;
        dst = zc + (size_t)(m - R_LAT) * 1024;
        v = 2;
      }
      const float* gate = mod + (size_t)v * 3072 + 2048;
      float4 xv[2][4], gv[2][4];
#pragma unroll
      for (int nt = 0; nt < 2; ++nt) {
        int n = ntile * 128 + wn * 64 + nt * 32 + 4 * h;
#pragma unroll
        for (int g = 0; g < 4; ++g) {
          xv[nt][g] = *(const float4*)(xin + n + 8 * g);
          gv[nt][g] = *(const float4*)(gate + n + 8 * g);
        }
      }
#pragma unroll
      for (int nt = 0; nt < 2; ++nt) {
        int n = ntile * 128 + wn * 64 + nt * 32 + 4 * h;
#pragma unroll
        for (int g = 0; g < 4; ++g) {
          f32x16& a = acc[nt][mt];
          float4 o;
          o.x = ALPHA * xv[nt][g].x + gv[nt][g].x * a[4 * g];
          o.y = ALPHA * xv[nt][g].y + gv[nt][g].y * a[4 * g + 1];
          o.z = ALPHA * xv[nt][g].z + gv[nt][g].z * a[4 * g + 2];
          o.w = ALPHA * xv[nt][g].w + gv[nt][g].w * a[4 * g + 3];
          *(float4*)(dst + n + 8 * g) = o;
        }
      }
    }
  }
}

DI void phase_prep(const P& p, int l, unsigned char* smem) {
  if (blockIdx.x == 0 && tidx() == 0) ((unsigned*)(p.ws + OFF_CTR))[l] = 0u;
  const int nlat = S_LAT / 16, nctx = (l == 0) ? LC / 16 : 0;
  for (int item = blockIdx.x; item < nlat; item += gridDim.x) filter_item(p, l, S_LAT, item * 16, false, smem);
  for (int item = (int)gridDim.x - 1 - (int)blockIdx.x; item < nctx; item += gridDim.x) filter_item(p, l, LC, item * 16, true, smem);
  phase_convert(p, l, smem);
}

constexpr int NPHASE = 17;

__global__ void __launch_bounds__(256, 2) mega(P p) {
  __shared__ __attribute__((aligned(16))) unsigned char smem[73728];
  __shared__ float rs[128];
  __shared__ int s_item;
  cg::grid_group grid = cg::this_grid();
  if (p.phase_lo < 0) grid.sync();
  __shared__ uint4 xb_words;
  if (threadIdx.x == 0) xb_words = make_uint4(0u, 0u, 0u, 0u);
  __syncthreads();
  XcdBarrier xb = xcd_barrier_post((unsigned*)(p.ws + OFF_BAR), (volatile LAS unsigned*)&xb_words);
  for (int ph = p.phase_lo; ph < p.phase_hi; ++ph) {
#ifndef PH_MASK
#define PH_MASK 0x1ff
#endif
    if (ph == 0) {
      if (PH_MASK & 0x100) { phase_mod(p, smem); phase_prep(p, 0, smem); }
    } else {
      int l = (ph - 1) >> 3, sub = (ph - 1) & 7;
      switch (sub) {
#ifndef EXP
#define EXP 0
#endif
        case 0: if (PH_MASK & 1) { if (l == 0) phase_ln0(p); } break;
        case 1: if (PH_MASK & 2) { phase_gemm1(p, l, smem); } break;
        case 2: if (PH_MASK & 4) { phase_hyprep(p, l, smem);  } break;
        case 3: if (PH_MASK & 8) { phase_upproj(p, l, smem, rs); } break;
        case 4: if (PH_MASK & 16) { phase_mixers(p, l, smem, &s_item); } break;
        case 5: if (PH_MASK & 32) { phase_merge(p, l, smem); } break;
        case 6: if (PH_MASK & 64) { phase_out(p, l, smem); } break;
        case 7: if (PH_MASK & 128) { phase_lnG(p, l); if (l == 0) phase_prep(p, 1, smem); } break;
      }
    }
    if (ph + 1 < p.phase_hi && ph != 9) { xcd_barrier(xb); }
  }
}

extern "C" void kernel_launch(void* const* d_in, const int* in_sizes, int n_in, void* d_out, int out_size, void* d_ws,
                              size_t ws_size, hipStream_t stream) {
  static int grid_blocks = 0;
  if (!grid_blocks) {
    int dev = 0, cus = 0, per_cu = 0;
    hipGetDevice(&dev);
    hipDeviceGetAttribute(&cus, hipDeviceAttributeMultiprocessorCount, dev);
    hipOccupancyMaxActiveBlocksPerMultiprocessor(&per_cu, mega, 256, 0);
    if (per_cu < 1) per_cu = 1;
    if (per_cu > 2) per_cu = 2;
    grid_blocks = cus * per_cu;
  }
  P p;
  memset(&p, 0, sizeof(p));
  const float** f = (const float**)&p;
  for (int i = 0; i < 29; ++i) f[i] = (const float*)d_in[i];
  p.out = (float*)d_out;
  p.ws = (char*)d_ws;
#if MULTI_LAUNCH
  for (int ph = 0; ph < NPHASE; ++ph) {
    p.phase_lo = ph;
    p.phase_hi = ph + 1;
    hipLaunchKernelGGL(mega, dim3(grid_blocks), dim3(256), 0, stream, p);
  }
#else
  p.phase_lo = 0;
  p.phase_hi = NPHASE;
  hipMemsetAsync((char*)d_ws + OFF_CTR, 0, 256 + 16384, stream);
  void* args[] = {&p};
  hipError_t e = hipLaunchCooperativeKernel((void*)mega, dim3(grid_blocks), dim3(256), args, 0, stream);
  if (e != hipSuccess) fprintf(stderr, "cooperative launch failed: %s (grid %d)\n", hipGetErrorString(e), grid_blocks);
#endif
}
```
